# Optimizing an MI355X kernel written in HIP

```python
import math
import jax, jax.numpy as jnp
from jax import lax
import numpy as np

D_MODEL = 2048
BATCH = 4
SEQ = 4096
DEPTH = 4

HEAD_DIM = 128
ROPE_THETA = 10000.0
NORM_EPS = 1e-6

A_Q_HEADS = 8
A_KV_HEADS = 2
A_GROUP = A_Q_HEADS // A_KV_HEADS
A_RADIUS = 128
A_BLOCK = 128

B_PATTERNS = ((128, 1), (512, 4), (2048, 16))
B_GROUPS = len(B_PATTERNS)
B_HEADS_PER_GROUP = 4
B_HEADS = B_GROUPS * B_HEADS_PER_GROUP
B_BLOCK = 64

C_HEADS = 8
GRID_W = 64
C_WIN_ROWS = 8
C_WIN_COLS = 16

N_BRANCH = 3
A_Q_W = A_Q_HEADS * HEAD_DIM
A_KV_W = A_KV_HEADS * HEAD_DIM
B_W = B_HEADS * HEAD_DIM
B_OUT_W = B_HEADS_PER_GROUP * HEAD_DIM
C_W = C_HEADS * HEAD_DIM
IN_WIDTHS = (A_Q_W, A_KV_W, A_KV_W, B_W, B_W, B_W, C_W, C_W, C_W, N_BRANCH * D_MODEL)
N_IN = sum(IN_WIDTHS)

D_FF = ((8 * D_MODEL + 3 * 256 - 1) // (3 * 256)) * 256

kernel_name = 'hybrid_gated_local_dilated_grid_attention_encoder'


def rmsnorm(x, g):
    x32 = x.astype(jnp.float32)
    y = x32 * lax.rsqrt(jnp.mean(x32 * x32, axis=-1, keepdims=True) + NORM_EPS)
    return (y * g.astype(jnp.float32)).astype(x.dtype)


def rope_tables(n):
    half = HEAD_DIM // 2
    inv_freq = ROPE_THETA ** (-jnp.arange(half, dtype=jnp.float32) * 2.0 / HEAD_DIM)
    ang = jnp.arange(n, dtype=jnp.float32)[:, None] * inv_freq[None, :]
    return jnp.cos(ang), jnp.sin(ang)


def apply_rope(x, cos, sin):
    half = HEAD_DIM // 2
    x32 = x.astype(jnp.float32)
    x1, x2 = x32[..., :half], x32[..., half:]
    return jnp.concatenate([x1 * cos - x2 * sin, x2 * cos + x1 * sin], axis=-1).astype(x.dtype)


def banded_attention(q, k, v, radius, block, sink=None):
    bsz, hk, grp, n, dh = q.shape
    nb = n // block
    width = block + 2 * radius
    pad = ((0, 0), (0, 0), (radius, radius), (0, 0))
    idx = jnp.arange(nb)[:, None] * block + jnp.arange(width)[None, :]
    kb = jnp.pad(k, pad)[:, :, idx]
    vb = jnp.pad(v, pad)[:, :, idx]
    qb = q.reshape(bsz, hk, grp, nb, block, dh)
    s = jnp.einsum('bhgnqd,bhnkd->bhgnqk', qb, kb, preferred_element_type=jnp.float32) * (dh ** -0.5)
    qpos = (jnp.arange(nb)[:, None] * block + jnp.arange(block)[None, :])[:, :, None]
    kpos = (idx - radius)[:, None, :]
    valid = (jnp.abs(kpos - qpos) <= radius) & (kpos >= 0) & (kpos < n)
    s = jnp.where(valid, s, -jnp.inf)
    m = jnp.max(s, axis=-1, keepdims=True)
    if sink is not None:
        sk = sink.astype(jnp.float32).reshape(1, hk, grp, 1, 1, 1)
        m = jnp.maximum(m, sk)
    p = jnp.exp(s - m)
    denom = jnp.sum(p, axis=-1, keepdims=True)
    if sink is not None:
        denom = denom + jnp.exp(sk - m)
    o = jnp.einsum('bhgnqk,bhnkd->bhgnqd', (p / denom).astype(v.dtype), vb)
    lse = (m + jnp.log(denom))[..., 0]
    return o.reshape(bsz, hk, grp, n, dh), lse.reshape(bsz, hk, grp, n)


def mixer_a(qa, ka, va, cos, sin, gq, gk, sink):
    bsz, n, _ = qa.shape
    q = qa.reshape(bsz, n, A_KV_HEADS, A_GROUP, HEAD_DIM).transpose(0, 2, 3, 1, 4)
    k = ka.reshape(bsz, n, A_KV_HEADS, HEAD_DIM).transpose(0, 2, 1, 3)
    v = va.reshape(bsz, n, A_KV_HEADS, HEAD_DIM).transpose(0, 2, 1, 3)
    q = apply_rope(rmsnorm(q, gq), cos, sin)
    k = apply_rope(rmsnorm(k, gk), cos, sin)
    o, _ = banded_attention(q, k, v, A_RADIUS, math.gcd(n, A_BLOCK),
                            sink.reshape(A_KV_HEADS, A_GROUP))
    return o.transpose(0, 3, 1, 2, 4).reshape(bsz, n, A_Q_W)


def to_residue_classes(t, dil):
    bsz, h, n, dh = t.shape
    return t.reshape(bsz, h, n // dil, dil, dh).transpose(0, 1, 3, 2, 4).reshape(bsz, h * dil, n // dil, dh)


def mixer_b(qb, kb, vb, cos, sin, gq, gk):
    bsz, n, _ = qb.shape
    hg = B_HEADS_PER_GROUP

    def heads(t):
        return t.reshape(bsz, n, B_GROUPS, hg, HEAD_DIM).transpose(0, 2, 3, 1, 4)

    q = apply_rope(rmsnorm(heads(qb), gq), cos, sin)
    k = apply_rope(rmsnorm(heads(kb), gk), cos, sin)
    v = heads(vb)
    outs, lses = [], []
    for g, (window, dil) in enumerate(B_PATTERNS):
        m = n // dil
        o, lse = banded_attention(to_residue_classes(q[:, g], dil)[:, :, None],
                                  to_residue_classes(k[:, g], dil),
                                  to_residue_classes(v[:, g], dil),
                                  window // (2 * dil), math.gcd(m, B_BLOCK))
        o = o[:, :, 0].reshape(bsz, hg, dil, m, HEAD_DIM).transpose(0, 1, 3, 2, 4).reshape(bsz, hg, n, HEAD_DIM)
        lse = lse[:, :, 0].reshape(bsz, hg, dil, m).transpose(0, 1, 3, 2).reshape(bsz, hg, n)
        outs.append(o)
        lses.append(lse)
    o = jnp.stack(outs, axis=1)
    lse = jnp.stack(lses, axis=1)
    w = jax.nn.softmax(lse, axis=1)
    out = jnp.einsum('bghl,bghld->bhld', w.astype(o.dtype), o)
    return out.transpose(0, 2, 1, 3).reshape(bsz, n, B_OUT_W)


def mixer_c(qc, kc, vc, gq, gk, rpb):
    bsz, n, _ = qc.shape
    rows = n // GRID_W
    wr = min(C_WIN_ROWS, rows)

    def grid(t):
        return t.reshape(bsz, rows, GRID_W, C_HEADS, HEAD_DIM).transpose(0, 3, 1, 2, 4)

    q = rmsnorm(grid(qc), gq)
    k = rmsnorm(grid(kc), gk)
    v = grid(vc)
    r = jnp.arange(rows)
    row_start = jnp.clip(r - wr // 2, 0, rows - wr)
    krow = row_start[:, None] + jnp.arange(wr)[None, :]
    kg = k[:, :, krow]
    vg = v[:, :, krow]
    s = jnp.einsum('bhrcd,bhrwkd->bhrcwk', q, kg, preferred_element_type=jnp.float32) * (HEAD_DIM ** -0.5)
    cq = jnp.arange(GRID_W)
    col_start = jnp.clip(cq - C_WIN_COLS // 2, 0, GRID_W - C_WIN_COLS)
    col_ok = (cq[None, :] >= col_start[:, None]) & (cq[None, :] < col_start[:, None] + C_WIN_COLS)
    drow = krow - r[:, None]
    dcol = jnp.clip(cq[None, :] - cq[:, None], -(C_WIN_COLS - 1), C_WIN_COLS - 1)
    bias = rpb[:, drow[:, None, :, None] + (C_WIN_ROWS - 1), dcol[None, :, None, :] + (C_WIN_COLS - 1)]
    s = s + bias[None].astype(jnp.float32)
    s = jnp.where(col_ok[:, None, :], s, -jnp.inf)
    p = jax.nn.softmax(s.reshape(bsz, C_HEADS, rows, GRID_W, wr * GRID_W), axis=-1).reshape(s.shape)
    o = jnp.einsum('bhrcwk,bhrwkd->bhrcd', p.astype(v.dtype), vg)
    return o.transpose(0, 2, 3, 1, 4).reshape(bsz, n, C_W)


def setup_inputs(seed: int = 0) -> dict:
    key = jax.random.key(seed)
    ks = jax.random.split(key, 14)
    f32 = jnp.float32

    def w(k, shape, fan_in):
        return jax.random.normal(k, shape, f32) * (fan_in ** -0.5)

    return {
        'x': jax.random.normal(ks[0], (BATCH, SEQ, D_MODEL), f32),
        'norm1_g': 1.0 + 0.02 * jax.random.normal(ks[1], (DEPTH, D_MODEL), f32),
        'w_in': w(ks[2], (DEPTH, D_MODEL, N_IN), D_MODEL),
        'qk_norm_g': 1.0 + 0.02 * jax.random.normal(ks[3], (DEPTH, 6, HEAD_DIM), f32),
        'sink_a': jax.random.normal(ks[4], (DEPTH, A_Q_HEADS), f32),
        'rpb_c': 0.1 * jax.random.normal(ks[5], (DEPTH, C_HEADS, 2 * C_WIN_ROWS - 1, 2 * C_WIN_COLS - 1), f32),
        'w_br_a': w(ks[6], (DEPTH, A_Q_W, D_MODEL), A_Q_W),
        'w_br_b': w(ks[7], (DEPTH, B_OUT_W, D_MODEL), B_OUT_W),
        'w_br_c': w(ks[8], (DEPTH, C_W, D_MODEL), C_W),
        'w_o': w(ks[9], (DEPTH, D_MODEL, D_MODEL), D_MODEL),
        'norm2_g': 1.0 + 0.02 * jax.random.normal(ks[10], (DEPTH, D_MODEL), f32),
        'w_gate_up': w(ks[11], (DEPTH, D_MODEL, 2 * D_FF), D_MODEL),
        'w_down': w(ks[12], (DEPTH, D_FF, D_MODEL), D_FF),
    }


def reference(x, norm1_g, w_in, qk_norm_g, sink_a, rpb_c, w_br_a, w_br_b, w_br_c, w_o,
              norm2_g, w_gate_up, w_down):
    bsz, n, _ = x.shape
    cos, sin = rope_tables(n)
    split_points = []
    acc = 0
    for wdt in IN_WIDTHS[:-1]:
        acc += wdt
        split_points.append(acc)
    for i in range(DEPTH):
        h = rmsnorm(x, norm1_g[i])
        proj = h @ w_in[i]
        qa, ka, va, qb, kb, vb, qc, kc, vc, gl = jnp.split(proj, split_points, axis=-1)
        g = qk_norm_g[i]
        oa = mixer_a(qa, ka, va, cos, sin, g[0], g[1], sink_a[i])
        ob = mixer_b(qb, kb, vb, cos, sin, g[2], g[3])
        oc = mixer_c(qc, kc, vc, g[4], g[5], rpb_c[i])
        gates = jax.nn.sigmoid(gl.astype(jnp.float32)).astype(x.dtype).reshape(bsz, n, N_BRANCH, D_MODEL)
        merged = (gates[:, :, 0] * (oa @ w_br_a[i])
                  + gates[:, :, 1] * (ob @ w_br_b[i])
                  + gates[:, :, 2] * (oc @ w_br_c[i]))
        x = x + merged @ w_o[i]
        h2 = rmsnorm(x, norm2_g[i])
        gt, up = jnp.split(h2 @ w_gate_up[i], 2, axis=-1)
        x = x + (jax.nn.silu(gt) * up) @ w_down[i]
    return x
```

```cpp
#include <hip/hip_runtime.h>
#include <cstdio>
#include <cstdint>
#include <cmath>

constexpr int DM = 2048, NBATCH = 4, SEQ = 4096, M = NBATCH * SEQ, DEPTH = 4, HD = 128;
constexpr int NIN = 15360, DFF = 5632, NGU = 2 * DFF, KBR = 2560;
constexpr int OFF_QA = 0, OFF_KA = 1024, OFF_VA = 1280, OFF_QB = 1536, OFF_KB = 3072, OFF_VB = 4608, OFF_QC = 6144, OFF_KC = 7168, OFF_VC = 8192, OFF_G = 9216;
constexpr int OC_A = 0, OC_B = 1024, OC_C = 1536;
constexpr float NORM_EPS = 1e-6f;
constexpr float ATT_SCALE = 0.08838834764831845f;
constexpr int NWAVES = 8;

constexpr size_t MiB = 1u << 20;
constexpr size_t WS_CTL = 0, CTL_ZERO_BYTES = 1 * MiB;
constexpr size_t WS_ROPE = 1 * MiB;
constexpr size_t WS_W = 4 * MiB;
constexpr size_t LW_IN = 0, LW_BR = LW_IN + (size_t)NIN * DM * 2, LW_O = LW_BR + (size_t)DM * KBR * 2, LW_GU = LW_O + (size_t)DM * DM * 2,
                 LW_D = LW_GU + (size_t)NGU * DM * 2, LW_SZ = LW_D + (size_t)DM * DFF * 2;
static_assert(LW_SZ == 144 * MiB, "per-layer bf16 weights");
constexpr size_t WS_XN = WS_W + DEPTH * LW_SZ;
constexpr size_t WS_PROJ = WS_XN + (size_t)M * DM * 2;
constexpr size_t WS_HID = WS_PROJ;
constexpr size_t WS_OCAT = WS_PROJ + (size_t)M * NIN * 2;
constexpr size_t WS_MRG = WS_OCAT + (size_t)M * KBR * 2;
constexpr size_t WS_MACC = WS_MRG + (size_t)M * DM * 2;
constexpr size_t WS_END = WS_MACC + (size_t)M * DM * 4;
constexpr int CW_BAR = 4096;

constexpr int RING_OFF = 0, RING_BYTES = 131072;
constexpr int MISC_OFF = RING_BYTES + 8192;
constexpr int LDS_BYTES = 147456;

#define GAS __attribute__((address_space(1)))
#define LAS __attribute__((address_space(3)))
typedef unsigned short bf16;
typedef unsigned v4u __attribute__((ext_vector_type(4)));
typedef unsigned v2u __attribute__((ext_vector_type(2)));
typedef float f32x4 __attribute__((ext_vector_type(4)));
typedef float f32x2 __attribute__((ext_vector_type(2)));
typedef short bf16x8 __attribute__((ext_vector_type(8)));
typedef _Float16 h16x2 __attribute__((ext_vector_type(2)));

__device__ __forceinline__ unsigned cvt_pk_bf16(float lo, float hi) { unsigned r; asm volatile("v_cvt_pk_bf16_f32 %0, %1, %2" : "=v"(r) : "v"(lo), "v"(hi)); return r; }
__device__ __forceinline__ unsigned cvt_pk_f16(float lo, float hi) { h16x2 h = {(_Float16)lo, (_Float16)hi}; return __builtin_bit_cast(unsigned, h); }
__device__ __forceinline__ float bf_lo(unsigned u) { return __uint_as_float(u << 16); }
__device__ __forceinline__ float bf_hi(unsigned u) { return __uint_as_float(u & 0xffff0000u); }
__device__ __forceinline__ float h_lo(unsigned u) { h16x2 h = __builtin_bit_cast(h16x2, u); return (float)h.x; }
__device__ __forceinline__ float h_hi(unsigned u) { h16x2 h = __builtin_bit_cast(h16x2, u); return (float)h.y; }
__device__ __forceinline__ float wave_sum(float v) {
#pragma unroll
    for (int o = 1; o < 64; o <<= 1) v += __shfl_xor(v, o);
    return v;
}
__device__ __forceinline__ float sigmoidf_fast(float x) { return __builtin_amdgcn_rcpf(1.0f + __builtin_amdgcn_exp2f(-1.4426950408889634f * x)); }

__host__ __device__ inline int slot32_v(int c32) { return 16 * ((c32 >> 2) & 1) + 4 * (c32 >> 3) + (c32 & 3); }
__host__ __device__ inline int slot128_qk(int d) { const int n = d >> 6, dlo = d & 63; return 32 * (dlo >> 4) + 16 * n + 4 * ((dlo >> 2) & 3) + (dlo & 3); }
__host__ __device__ inline bool is_qk_col(int n) { return n < OFF_VA || (n >= OFF_QB && n < OFF_VB) || (n >= OFF_QC && n < OFF_VC); }
enum { MAP_NAT = 0, MAP_V = 1, MAP_IN = 2, MAP_GU = 3 };
template <int MAP> __host__ __device__ inline int map_row(int n) {
    if (MAP == MAP_NAT) return n;
    if (MAP == MAP_V) return (n & ~31) + slot32_v(n & 31);
    if (MAP == MAP_IN) return is_qk_col(n) ? (n & ~127) + slot128_qk(n & 127) : (n & ~31) + slot32_v(n & 31);
    const int up = n >= DFF ? 1 : 0, jh = n - up * DFF; return 256 * (jh >> 7) + 128 * up + (jh & 96) + slot32_v(jh & 31);
}
#define XB_TMO      128
#define XB_XCNT(j)  (256  + 64 * (j))
#define XB_XSUB(j)  (1280 + 64 * (j))
#define XB_XGEN(j)  (2304 + 64 * (j))
#define XB_TOP      3328
#define XB_TOPGEN   3392
#define XCD_BAR_WORDS 3456
#define XB_SPIN_CAP (1u << 18)

__device__ __forceinline__ unsigned xb_ld(unsigned* p)              { return __hip_atomic_load(p, __ATOMIC_RELAXED, __HIP_MEMORY_SCOPE_AGENT); }
__device__ __forceinline__ unsigned xb_add(unsigned* p, unsigned v) { return __hip_atomic_fetch_add(p, v, __ATOMIC_RELAXED, __HIP_MEMORY_SCOPE_AGENT); }
__device__ __forceinline__ unsigned xb_xcc_id() { return (unsigned)__builtin_amdgcn_s_getreg((3 << 11) | 20) & 0xFu; }
#define XB_SPIN(cond, bar) do { unsigned _sp = 0; while (cond) { __builtin_amdgcn_s_sleep(1); \
    if ((++_sp & 255u) == 0u) { if (xb_ld(&(bar)[XB_TMO])) break; if (_sp > XB_SPIN_CAP) { atomicAdd(&(bar)[XB_TMO], 1u); break; } } } } while (0)

struct XcdBarrier {
    unsigned* bar; unsigned x;
    volatile LAS unsigned* st;
};

__device__ __forceinline__ XcdBarrier xcd_barrier_post(unsigned* bar, volatile LAS unsigned* st) {
    XcdBarrier b; b.bar = bar; b.x = xb_xcc_id(); b.st = st;
    if (threadIdx.x == 0) (void)xb_add(&bar[XB_XCNT(b.x)], 1u);
    return b;
}
__device__ __forceinline__ void xcd_barrier_complete(unsigned* bar, unsigned x, unsigned& nloc, unsigned& nx) {
    const unsigned G = gridDim.x * gridDim.y * gridDim.z;
    unsigned sum, cnt, mine, sp = 0u;
    for (;;) {
        sum = 0u; cnt = 0u; mine = 0u;
#pragma unroll
        for (unsigned j = 0; j < 16; ++j) { const unsigned c = xb_ld(&bar[XB_XCNT(j)]); sum += c; cnt += (c > 0u) ? 1u : 0u; mine = (j == x) ? c : mine; }
        if (sum == G) break;
        __builtin_amdgcn_s_sleep(1);
        if ((++sp & 255u) == 0u) { if (xb_ld(&bar[XB_TMO])) break; if (sp > XB_SPIN_CAP) { atomicAdd(&bar[XB_TMO], 1u); break; } }
    }
    nloc = mine > 0u ? mine : 1u; nx = cnt > 0u ? cnt : 1u;
}

__device__ __forceinline__ void xcd_barrier(const XcdBarrier& b) {
    asm volatile("s_waitcnt vmcnt(0)" ::: "memory");
    __syncthreads();
    if (threadIdx.x == 0) {
        unsigned* bar = b.bar;
        __builtin_amdgcn_s_waitcnt(0);
        unsigned nloc = b.st[0], nx = b.st[1];
        if (nloc == 0u) { xcd_barrier_complete(bar, b.x, nloc, nx); b.st[0] = nloc; b.st[1] = nx; }
        const unsigned old = xb_add(&bar[XB_XSUB(b.x)], 1u);
        const unsigned gen = old / nloc;
        if (old + 1u == (gen + 1u) * nloc) {
            __builtin_amdgcn_fence(__ATOMIC_RELEASE, "agent");
            asm volatile("s_waitcnt vmcnt(0)" ::: "memory");
            const unsigned og = xb_add(&bar[XB_TOP], 1u);
            const unsigned tg = og / nx;
            if (og + 1u == (tg + 1u) * nx) xb_add(&bar[XB_TOPGEN], 1u);
            else XB_SPIN(xb_ld(&bar[XB_TOPGEN]) == tg, bar);
            __builtin_amdgcn_fence(__ATOMIC_ACQUIRE, "agent");
            xb_add(&bar[XB_XGEN(b.x)], 1u);
            asm volatile("s_waitcnt vmcnt(0)" ::: "memory");
        } else {
            XB_SPIN(xb_ld(&bar[XB_XGEN(b.x)]) == gen, bar);
            __builtin_amdgcn_fence(__ATOMIC_ACQUIRE, "agent");
            asm volatile("s_waitcnt vmcnt(0)" ::: "memory");
        }
    }
    __syncthreads();
}
namespace pg8 {
#define PG8_LAS __attribute__((address_space(3)))
typedef unsigned short bf16_t;
constexpr int BM = 256, BK = 64, HALF = 128, HTB = HALF * BK * 2  , STAGE_BYTES = 8 * HTB, NXCD = 8, WGM = 8;
__host__ __device__ __forceinline__ int lds_byte(int r, int c) { const int st = (r >> 4) * 2 + (c >> 5), rr = r & 15, cc = c & 31, ob = rr * 64 + cc * 2; return st * 1024 + (ob ^ (((ob >> 9) & 1) << 5)); }
__host__ __device__ __forceinline__ void stage_rc(int b, int& R, int& C) { const int st = b / 1024, sb = b % 1024, swz = sb ^ (((sb >> 9) & 1) << 5); R = (st >> 1) * 16 + swz / 64; C = (st & 1) * 32 + (swz % 64) / 2; }
struct Unit { int pm, pn; };
struct Gemm { const bf16_t* A; const bf16_t* Bt; int lda, ldb, M, N, K; };
struct StaticOrder {
    int nM, nN, nwg, G, c;
    __host__ __device__ void init(int M, int N, int G_, int c_) { nM = M / BM; nN = N / BM; nwg = nM * nN; G = G_; c = c_; }
    __host__ __device__ bool next(int i, Unit& u) const {
        const long L = (long)i * G + c; if (L >= nwg) return false;
        int wgid = (int)L; { const int q = nwg / NXCD, r = nwg % NXCD, xcd = wgid % NXCD, off = wgid / NXCD; wgid = (xcd < r ? xcd * (q + 1) : r * (q + 1) + (xcd - r) * q) + off; }
        const int nig = WGM * nN, gid = wgid / nig, fm = gid * WGM, gsz = (nM - fm) < WGM ? (nM - fm) : WGM;
        u.pm = fm + ((wgid % nig) % gsz); u.pn = (wgid % nig) / gsz; return true;
    }
    __device__ __forceinline__ void a_ready(const Unit&) const {}
    __device__ __forceinline__ void done(const Unit&) const {}
};
template <class Epi, class Sched, bool ALIGN_EPI = false, bool SP2 = false>
__device__ __forceinline__ void gemm_phase(PG8_LAS unsigned char* lds, const Gemm g, const Sched& S, const Epi& E) {
    int tid = threadIdx.x; asm volatile("" : "+v"(tid));
    const int wid = __builtin_amdgcn_readfirstlane(tid >> 6), lane = tid & 63, wr = wid >> 2, wc = wid & 3, fr = lane & 15, fq = lane >> 4;
    const int K = g.K, nt = K / BK, lda = g.lda, ldb = g.ldb;
    unsigned voffA[2], voffB[2];
#pragma unroll
    for (int i = 0; i < 2; ++i) { int R, C; stage_rc(tid * 16 + i * 8192, R, C);
        voffA[i] = (unsigned)(R * lda + C) * 2u; voffB[i] = (unsigned)(R * ldb + C) * 2u; }
    const size_t kstep = (size_t)(BK * 2);
    const size_t hstepA = (size_t)HALF * lda * 2, hstepB = (size_t)HALF * ldb * 2;
    const size_t tstepA = 2 * hstepA, tstepB = 2 * hstepB;
    const unsigned ldsw = (unsigned)wid * 1024u;
    const int aoff = lds_byte(wr * 64 + fr, fq * 8), boff = lds_byte(wc * 32 + fr, fq * 8);
#define PG8_SA(b, h) (((b) * 2 + (h)) * HTB)
#define PG8_SB(b, h) ((4 + (b) * 2 + (h)) * HTB)
#define PG8_STAGE(bufoff, gbase, voff) do { _Pragma("unroll") for (int _i = 0; _i < 2; ++_i) \
        __builtin_amdgcn_global_load_lds((const unsigned*)((const char*)(gbase) + (voff)[_i]), (PG8_LAS unsigned*)(lds + (bufoff) + ldsw + _i * 8192), 16, 0, 0); } while (0)
#define PG8_LDA(dst, b, h) do { _Pragma("unroll") for (int m = 0; m < 4; ++m) _Pragma("unroll") for (int k = 0; k < 2; ++k) dst[m][k] = *(const PG8_LAS bf16x8*)(lds + PG8_SA(b, h) + aoff + m * 2048 + k * 1024); } while (0)
#define PG8_LDB(dst, b, h) do { _Pragma("unroll") for (int n = 0; n < 2; ++n) _Pragma("unroll") for (int k = 0; k < 2; ++k) dst[n][k] = *(const PG8_LAS bf16x8*)(lds + PG8_SB(b, h) + boff + n * 2048 + k * 1024); } while (0)
#define PG8_MMA(ai, bj, At, Bt) do { __builtin_amdgcn_s_setprio(1); _Pragma("unroll") for (int m = 0; m < 4; ++m) _Pragma("unroll") for (int n = 0; n < 2; ++n) _Pragma("unroll") for (int k = 0; k < 2; ++k) \
        acc[ai][bj][m][n] = __builtin_amdgcn_mfma_f32_16x16x32_bf16(Bt[n][k], At[m][k], acc[ai][bj][m][n], 0, 0, 0); __builtin_amdgcn_s_setprio(0); } while (0)
#define PG8_WAIT_V(n) asm volatile("s_waitcnt vmcnt(" #n ")" ::: "memory")
#define PG8_WAIT_L(n) asm volatile("s_waitcnt lgkmcnt(" #n ")" ::: "memory")
#define PG8_BAR __builtin_amdgcn_s_barrier()
#define PG8_SCHED __builtin_amdgcn_sched_barrier(0)
    Unit cur, nxt; int ui = 0;
    if (!S.next(0, cur)) return;
    f32x4 acc[2][2][4][2];
#pragma unroll
    for (int a = 0; a < 2; ++a)
#pragma unroll
        for (int b = 0; b < 2; ++b)
#pragma unroll
            for (int m = 0; m < 4; ++m)
#pragma unroll
                for (int n = 0; n < 2; ++n) acc[a][b][m][n] = (f32x4){0.f, 0.f, 0.f, 0.f};
    bf16x8 At[4][2], B0[2][2], B1[2][2];
    const char* cA = (const char*)g.A + (size_t)cur.pm * tstepA; const char* cB = (const char*)g.Bt + (size_t)cur.pn * tstepB;
    S.a_ready(cur);
    if constexpr (SP2) {
        PG8_STAGE(PG8_SB(0, 0), cB, voffB); PG8_STAGE(PG8_SB(0, 1), cB + hstepB, voffB); PG8_STAGE(PG8_SA(0, 0), cA, voffA); PG8_STAGE(PG8_SA(0, 1), cA + hstepA, voffA);
        if (wr == 1) PG8_BAR;
        PG8_WAIT_V(2); PG8_BAR;
        PG8_STAGE(PG8_SB(1, 0), cB + kstep, voffB); PG8_STAGE(PG8_SA(1, 0), cA + kstep, voffA); PG8_STAGE(PG8_SB(1, 1), cB + hstepB + kstep, voffB);
        PG8_WAIT_V(6); PG8_BAR;
    } else {
        PG8_STAGE(PG8_SB(0, 0), cB, voffB); PG8_STAGE(PG8_SA(0, 0), cA, voffA); PG8_STAGE(PG8_SB(0, 1), cB + hstepB, voffB); PG8_STAGE(PG8_SA(0, 1), cA + hstepA, voffA);
        if (wr == 1) PG8_BAR;
        PG8_WAIT_V(4); PG8_BAR;
        PG8_STAGE(PG8_SB(1, 0), cB + kstep, voffB); PG8_STAGE(PG8_SA(1, 0), cA + kstep, voffA); PG8_STAGE(PG8_SB(1, 1), cB + hstepB + kstep, voffB);
        PG8_WAIT_V(6); PG8_BAR;
    }
    for (;;) {
        const bool has_next = S.next(ui + 1, nxt);
        const char* nA = has_next ? (const char*)g.A + (size_t)nxt.pm * tstepA : cA; const char* nB = has_next ? (const char*)g.Bt + (size_t)nxt.pn * tstepB : cB;
        for (int t = 0; t < nt; t += 2) {
            const bool last = (t == nt - 2);
            const char* a1 = cA + (size_t)(t + 1) * kstep;
            const char* a2 = last ? nA : cA + (size_t)(t + 2) * kstep; const char* b2 = last ? nB : cB + (size_t)(t + 2) * kstep;
            const char* a3 = a2 + kstep; const char* b3 = b2 + kstep;
            if (last && has_next) S.a_ready(nxt);
            if constexpr (SP2) {
            PG8_LDB(B0, 0, 0); PG8_LDB(B1, 0, 1); PG8_SCHED; PG8_LDA(At, 0, 0); PG8_STAGE(PG8_SA(1, 1), a1 + hstepA, voffA);
            PG8_WAIT_V(8); PG8_WAIT_L(0); PG8_BAR; PG8_MMA(0, 0, At, B0); PG8_MMA(0, 1, At, B1); PG8_BAR; PG8_SCHED;
            PG8_LDA(At, 0, 1); PG8_STAGE(PG8_SB(0, 0), b2, voffB); PG8_STAGE(PG8_SB(0, 1), b2 + hstepB, voffB); PG8_STAGE(PG8_SA(0, 0), a2, voffA);
            PG8_WAIT_V(8); PG8_WAIT_L(0); PG8_BAR; PG8_MMA(1, 0, At, B0); PG8_MMA(1, 1, At, B1); PG8_BAR; PG8_SCHED;
            PG8_LDB(B0, 1, 0); PG8_LDB(B1, 1, 1); PG8_SCHED; PG8_LDA(At, 1, 0); PG8_STAGE(PG8_SA(0, 1), a2 + hstepA, voffA);
            PG8_WAIT_V(8); PG8_WAIT_L(0); PG8_BAR; PG8_MMA(0, 0, At, B0); PG8_MMA(0, 1, At, B1); PG8_BAR; PG8_SCHED;
            PG8_LDA(At, 1, 1); PG8_STAGE(PG8_SB(1, 0), b3, voffB); PG8_STAGE(PG8_SB(1, 1), b3 + hstepB, voffB); PG8_STAGE(PG8_SA(1, 0), a3, voffA);
            PG8_WAIT_V(8); PG8_WAIT_L(0); PG8_BAR; PG8_MMA(1, 0, At, B0); PG8_MMA(1, 1, At, B1); PG8_BAR; PG8_SCHED;
            } else {
            PG8_LDB(B0, 0, 0); PG8_SCHED; PG8_LDA(At, 0, 0); PG8_STAGE(PG8_SA(1, 1), a1 + hstepA, voffA);
            PG8_WAIT_L(8); PG8_BAR; PG8_WAIT_L(0); PG8_MMA(0, 0, At, B0); PG8_BAR; PG8_SCHED;
            PG8_LDB(B1, 0, 1); PG8_STAGE(PG8_SB(0, 0), b2, voffB);
            PG8_BAR; PG8_WAIT_L(0); PG8_MMA(0, 1, At, B1); PG8_BAR;
            PG8_LDA(At, 0, 1); PG8_STAGE(PG8_SA(0, 0), a2, voffA);
            PG8_BAR; PG8_WAIT_L(0); PG8_MMA(1, 0, At, B0); PG8_BAR; PG8_SCHED;
            PG8_STAGE(PG8_SB(0, 1), b2 + hstepB, voffB);
            PG8_WAIT_V(6); PG8_BAR; PG8_MMA(1, 1, At, B1); PG8_BAR;
            PG8_LDB(B0, 1, 0); PG8_SCHED; PG8_LDA(At, 1, 0); PG8_STAGE(PG8_SA(0, 1), a2 + hstepA, voffA);
            PG8_WAIT_L(8); PG8_BAR; PG8_WAIT_L(0); PG8_MMA(0, 0, At, B0); PG8_BAR; PG8_SCHED;
            PG8_LDB(B1, 1, 1); PG8_STAGE(PG8_SB(1, 0), b3, voffB);
            PG8_BAR; PG8_WAIT_L(0); PG8_MMA(0, 1, At, B1); PG8_BAR;
            PG8_LDA(At, 1, 1); PG8_STAGE(PG8_SA(1, 0), a3, voffA);
            PG8_BAR; PG8_WAIT_L(0); PG8_MMA(1, 0, At, B0); PG8_BAR; PG8_SCHED;
            PG8_STAGE(PG8_SB(1, 1), b3 + hstepB, voffB);
            PG8_WAIT_V(6); PG8_BAR; PG8_MMA(1, 1, At, B1); PG8_BAR;
            }
        }
        if constexpr (ALIGN_EPI) { if (wr == 0) PG8_BAR; }
        if constexpr (!Epi::AFTER_DRAIN) { E(acc, cur, wr, wc, fr, fq); S.done(cur); }
        if (!has_next) break;
#pragma unroll
        for (int a = 0; a < 2; ++a)
#pragma unroll
            for (int b = 0; b < 2; ++b)
#pragma unroll
                for (int m = 0; m < 4; ++m)
#pragma unroll
                    for (int n = 0; n < 2; ++n) acc[a][b][m][n] = (f32x4){0.f, 0.f, 0.f, 0.f};
        cur = nxt; cA = nA; cB = nB; ++ui;
        if constexpr (ALIGN_EPI) { if (wr == 1) PG8_BAR; }
    }
    PG8_WAIT_V(0);
    if constexpr (!ALIGN_EPI) { if (wr == 0) PG8_BAR; }
    PG8_BAR;
    if constexpr (Epi::AFTER_DRAIN) { E.fused(acc, cur, wr, wc, fr, fq, lds, wid, lane); S.done(cur); }
#undef PG8_SA
#undef PG8_SB
#undef PG8_STAGE
#undef PG8_LDA
#undef PG8_LDB
#undef PG8_MMA
#undef PG8_WAIT_V
#undef PG8_WAIT_L
#undef PG8_BAR
#undef PG8_SCHED
}
}
namespace pg8 {
struct EpiProj {
    static constexpr bool AFTER_DRAIN = false;
    bf16_t* P;
    __device__ __forceinline__ void operator()(const f32x4 (&acc)[2][2][4][2], const Unit& u, int wr, int wc, int fr, int fq) const {
        const int row0 = u.pm * BM + wr * 64 + fr, col0 = u.pn * BM + wc * 32 + 8 * fq; const bool gate = u.pn >= OFF_G / BM;
#pragma unroll
        for (int ai = 0; ai < 2; ++ai)
#pragma unroll
            for (int m = 0; m < 4; ++m) { bf16_t* rowp = P + (size_t)(row0 + ai * HALF + m * 16) * NIN + col0;
#pragma unroll
                for (int bj = 0; bj < 2; ++bj) { const f32x4 v0 = acc[ai][bj][m][0], v1 = acc[ai][bj][m][1]; v4u w;
                    if (gate) { w.x = cvt_pk_f16(sigmoidf_fast(v0[0]), sigmoidf_fast(v0[1])); w.y = cvt_pk_f16(sigmoidf_fast(v0[2]), sigmoidf_fast(v0[3]));
                                w.z = cvt_pk_f16(sigmoidf_fast(v1[0]), sigmoidf_fast(v1[1])); w.w = cvt_pk_f16(sigmoidf_fast(v1[2]), sigmoidf_fast(v1[3])); }
                    else { w.x = cvt_pk_bf16(v0[0], v0[1]); w.y = cvt_pk_bf16(v0[2], v0[3]); w.z = cvt_pk_bf16(v1[0], v1[1]); w.w = cvt_pk_bf16(v1[2], v1[3]); }
                    *(v4u*)(rowp + bj * HALF) = w; } }
    }
};
template <int MODE> struct EpiGateAcc {
    static constexpr bool AFTER_DRAIN = false;
    const bf16_t* G; float* macc; bf16_t* mrg;
    __device__ __forceinline__ void operator()(const f32x4 (&acc)[2][2][4][2], const Unit& u, int wr, int wc, int fr, int fq) const {
        const int row0 = u.pm * BM + wr * 64 + fr, col0 = u.pn * BM + wc * 32 + 8 * fq;
#pragma unroll
        for (int ai = 0; ai < 2; ++ai)
#pragma unroll
            for (int m = 0; m < 4; ++m) { const int r = row0 + ai * HALF + m * 16;
#pragma unroll
                for (int bj = 0; bj < 2; ++bj) { const int c = col0 + bj * HALF;
                    const v4u gw = *(const v4u*)(G + (size_t)r * NIN + c);
                    f32x4 a0 = acc[ai][bj][m][0], a1 = acc[ai][bj][m][1];
                    a0[0] *= h_lo(gw.x); a0[1] *= h_hi(gw.x); a0[2] *= h_lo(gw.y); a0[3] *= h_hi(gw.y);
                    a1[0] *= h_lo(gw.z); a1[1] *= h_hi(gw.z); a1[2] *= h_lo(gw.w); a1[3] *= h_hi(gw.w);
                    float* mp = macc + (size_t)r * DM + c;
                    if (MODE >= 1) { a0 += *(const f32x4*)mp; a1 += *(const f32x4*)(mp + 4); }
                    if (MODE <= 1) { *(f32x4*)mp = a0; *(f32x4*)(mp + 4) = a1; }
                    else { v4u w; w.x = cvt_pk_bf16(a0[0], a0[1]); w.y = cvt_pk_bf16(a0[2], a0[3]); w.z = cvt_pk_bf16(a1[0], a1[1]); w.w = cvt_pk_bf16(a1[2], a1[3]);
                           *(v4u*)(mrg + (size_t)r * DM + c) = w; } } }
    }
};
struct EpiResF32 {
    static constexpr bool AFTER_DRAIN = false;
    const float* base; float* out;
    __device__ __forceinline__ void operator()(const f32x4 (&acc)[2][2][4][2], const Unit& u, int wr, int wc, int fr, int fq) const {
        const int row0 = u.pm * BM + wr * 64 + fr, col0 = u.pn * BM + wc * 32 + 4 * fq;
#pragma unroll
        for (int ai = 0; ai < 2; ++ai)
#pragma unroll
            for (int m = 0; m < 4; ++m) { const size_t off = (size_t)(row0 + ai * HALF + m * 16) * DM + col0;
#pragma unroll
                for (int bj = 0; bj < 2; ++bj)
#pragma unroll
                    for (int n = 0; n < 2; ++n) { const f32x4 b = *(const f32x4*)(base + off + bj * HALF + n * 16); *(f32x4*)(out + off + bj * HALF + n * 16) = b + acc[ai][bj][m][n]; } }
    }
};
struct EpiSwiglu {
    static constexpr bool AFTER_DRAIN = false;
    bf16_t* H;
    __device__ __forceinline__ void operator()(const f32x4 (&acc)[2][2][4][2], const Unit& u, int wr, int wc, int fr, int fq) const {
        const int row0 = u.pm * BM + wr * 64 + fr, col0 = u.pn * HALF + wc * 32 + 8 * fq;
#pragma unroll
        for (int ai = 0; ai < 2; ++ai)
#pragma unroll
            for (int m = 0; m < 4; ++m) { float h[8];
#pragma unroll
                for (int n = 0; n < 2; ++n)
#pragma unroll
                    for (int j = 0; j < 4; ++j) { const float g = acc[ai][0][m][n][j], up = acc[ai][1][m][n][j]; h[4 * n + j] = g * sigmoidf_fast(g) * up; }
                v4u w; w.x = cvt_pk_bf16(h[0], h[1]); w.y = cvt_pk_bf16(h[2], h[3]); w.z = cvt_pk_bf16(h[4], h[5]); w.w = cvt_pk_bf16(h[6], h[7]);
                *(v4u*)(H + (size_t)(row0 + ai * HALF + m * 16) * DFF + col0) = w; }
    }
};
}
template <int MAP> __device__ __forceinline__ void cvt_unit(const float* __restrict__ W, int N, bf16* __restrict__ Bt, int ldb, int koff, const float* __restrict__ gain, int n0, int k0, int lane) {
    const int kg = lane >> 3, ng = lane & 7, nn0 = n0 + 4 * ng, r0 = map_row<MAP>(nn0);
#pragma unroll 1
    for (int pass = 0; pass < 4; pass += 2) {
        f32x4 v[2][8];
#pragma unroll
        for (int p = 0; p < 2; ++p)
#pragma unroll
            for (int i = 0; i < 8; ++i) v[p][i] = *(const f32x4*)(W + (size_t)(k0 + (pass + p) * 64 + 8 * kg + i) * N + nn0);
#pragma unroll
        for (int p = 0; p < 2; ++p) { const int kb = k0 + (pass + p) * 64 + 8 * kg;
            f32x4 g0 = {1.f, 1.f, 1.f, 1.f}, g1 = {1.f, 1.f, 1.f, 1.f};
            if (gain) { g0 = *(const f32x4*)(gain + kb); g1 = *(const f32x4*)(gain + kb + 4); }
#pragma unroll
            for (int nn = 0; nn < 4; ++nn) { v4u o;
                o.x = cvt_pk_bf16(v[p][0][nn] * g0[0], v[p][1][nn] * g0[1]); o.y = cvt_pk_bf16(v[p][2][nn] * g0[2], v[p][3][nn] * g0[3]);
                o.z = cvt_pk_bf16(v[p][4][nn] * g1[0], v[p][5][nn] * g1[1]); o.w = cvt_pk_bf16(v[p][6][nn] * g1[2], v[p][7][nn] * g1[3]);
                *(v4u*)(Bt + (size_t)(r0 + nn) * ldb + koff + kb) = o; } }
    }
}

struct Args { const float* in[13]; float* out; unsigned char* ws; float inv_freq[64]; int ph_lo, ph_hi; };
struct Frame {
    LAS unsigned char* lds;
    int tid, lane, wave, G, gw, ngw;
    unsigned char* ws;
};

constexpr int CU_IN = (NIN / 32) * (DM / 256), CU_BA = (DM / 32) * (1024 / 256), CU_BB = (DM / 32) * (512 / 256), CU_BC = CU_BA, CU_O = (DM / 32) * (DM / 256),
              CU_GU = (NGU / 32) * (DM / 256), CU_D = (DM / 32) * (DFF / 256), CU_LAYER = CU_IN + CU_BA + CU_BB + CU_BC + CU_O + CU_GU + CU_D;
static_assert(CU_LAYER == 9216, "conversion units per layer");

__device__ __forceinline__ void p0_prologue(const Frame& F, const Args& A) {
    const float* inv_freq = A.inv_freq;
    { f32x2* rope = (f32x2*)(F.ws + WS_ROPE);
      for (int e = blockIdx.x * (NWAVES * 64) + F.tid; e < SEQ * 64; e += F.G * NWAVES * 64) { const int pos = e >> 6, i = e & 63;
          double r = (double)pos * (double)inv_freq[i] * 0.15915494309189533577; r -= __builtin_floor(r);
          const float rf = (float)r; rope[e] = (f32x2){__builtin_amdgcn_cosf(rf), __builtin_amdgcn_sinf(rf)}; } }
    for (int u = F.gw; u < DEPTH * CU_LAYER; u += F.ngw) {
        const int layer = u / CU_LAYER; int r = u - layer * CU_LAYER;
        bf16* wl = (bf16*)(F.ws + WS_W + (size_t)layer * LW_SZ);
        if (r < CU_IN) { cvt_unit<MAP_IN>(A.in[2] + (size_t)layer * DM * NIN, NIN, (bf16*)((char*)wl + LW_IN), DM, 0, A.in[1] + layer * DM, 32 * (r % (NIN / 32)), 256 * (r / (NIN / 32)), F.lane); continue; } r -= CU_IN;
        if (r < CU_BA) { cvt_unit<MAP_V>(A.in[6] + (size_t)layer * 1024 * DM, DM, (bf16*)((char*)wl + LW_BR), KBR, 0, nullptr, 32 * (r % (DM / 32)), 256 * (r / (DM / 32)), F.lane); continue; } r -= CU_BA;
        if (r < CU_BB) { cvt_unit<MAP_V>(A.in[7] + (size_t)layer * 512 * DM, DM, (bf16*)((char*)wl + LW_BR), KBR, 1024, nullptr, 32 * (r % (DM / 32)), 256 * (r / (DM / 32)), F.lane); continue; } r -= CU_BB;
        if (r < CU_BC) { cvt_unit<MAP_V>(A.in[8] + (size_t)layer * 1024 * DM, DM, (bf16*)((char*)wl + LW_BR), KBR, 1536, nullptr, 32 * (r % (DM / 32)), 256 * (r / (DM / 32)), F.lane); continue; } r -= CU_BC;
        if (r < CU_O) { cvt_unit<MAP_NAT>(A.in[9] + (size_t)layer * DM * DM, DM, (bf16*)((char*)wl + LW_O), DM, 0, nullptr, 32 * (r % (DM / 32)), 256 * (r / (DM / 32)), F.lane); continue; } r -= CU_O;
        if (r < CU_GU) { cvt_unit<MAP_GU>(A.in[11] + (size_t)layer * DM * NGU, NGU, (bf16*)((char*)wl + LW_GU), DM, 0, A.in[10] + layer * DM, 32 * (r % (NGU / 32)), 256 * (r / (NGU / 32)), F.lane); continue; } r -= CU_GU;
        cvt_unit<MAP_NAT>(A.in[12] + (size_t)layer * DFF * DM, DM, (bf16*)((char*)wl + LW_D), DFF, 0, nullptr, 32 * (r % (DM / 32)), 256 * (r / (DM / 32)), F.lane);
    }
}

__device__ __forceinline__ void rms_rows(const Frame& F, const float* x, bf16* xn) {
    for (int row = F.gw; row < M; row += F.ngw) {
        const f32x4* xr = (const f32x4*)(x + (size_t)row * DM) + F.lane;
        f32x4 v[8]; float s = 0.f;
#pragma unroll
        for (int j = 0; j < 8; ++j) { v[j] = xr[64 * j]; s += (v[j][0] * v[j][0] + v[j][1] * v[j][1]) + (v[j][2] * v[j][2] + v[j][3] * v[j][3]); }
        const float rs = 1.0f / sqrtf(wave_sum(s) * (1.0f / DM) + NORM_EPS);
        v2u* o = (v2u*)(xn + (size_t)row * DM) + F.lane;
#pragma unroll
        for (int j = 0; j < 8; ++j) { v2u w; w.x = cvt_pk_bf16(v[j][0] * rs, v[j][1] * rs); w.y = cvt_pk_bf16(v[j][2] * rs, v[j][3] * rs); o[64 * j] = w; }
    }
}
__device__ __forceinline__ void qknorm_rope_rows(const Frame& F, bf16* proj, const float* qkg  ) {
    const f32x2* rope = (const f32x2*)(F.ws + WS_ROPE);
    const int sub = F.lane & 15, grp = F.lane >> 4;
    for (int it0 = F.gw * 4; it0 < M * 50; it0 += F.ngw * 4) {
        const int it = it0 + grp, row = it / 50, hh = it - row * 50;
        int col, gi; bool rp = true;
        if (hh < 8) { col = OFF_QA + 128 * hh; gi = 0; } else if (hh < 10) { col = OFF_KA + 128 * (hh - 8); gi = 1; }
        else if (hh < 22) { col = OFF_QB + 128 * (hh - 10); gi = 2; } else if (hh < 34) { col = OFF_KB + 128 * (hh - 22); gi = 3; }
        else if (hh < 42) { col = OFF_QC + 128 * (hh - 34); gi = 4; rp = false; } else { col = OFF_KC + 128 * (hh - 42); gi = 5; rp = false; }
        v4u* p = (v4u*)(proj + (size_t)row * NIN + col) + sub;
        const v4u w = *p;
        float a[4] = {bf_lo(w.x), bf_hi(w.x), bf_lo(w.y), bf_hi(w.y)}, b[4] = {bf_lo(w.z), bf_hi(w.z), bf_lo(w.w), bf_hi(w.w)};
        float ss = 0.f;
#pragma unroll
        for (int j = 0; j < 4; ++j) ss += a[j] * a[j] + b[j] * b[j];
        ss += __shfl_xor(ss, 1); ss += __shfl_xor(ss, 2); ss += __shfl_xor(ss, 4); ss += __shfl_xor(ss, 8);
        const float rs = 1.0f / sqrtf(ss * (1.0f / HD) + NORM_EPS);
        const f32x4 ga = *(const f32x4*)(qkg + gi * HD + 4 * sub), gb = *(const f32x4*)(qkg + gi * HD + 64 + 4 * sub);
#pragma unroll
        for (int j = 0; j < 4; ++j) { a[j] *= rs * ga[j]; b[j] *= rs * gb[j]; }
        if (rp) { const int pos = row & (SEQ - 1); const f32x2* cs = rope + pos * 64 + 4 * sub;
#pragma unroll
            for (int j = 0; j < 4; ++j) { const f32x2 c = cs[j]; const float x1 = a[j], x2 = b[j]; a[j] = x1 * c.x - x2 * c.y; b[j] = x2 * c.x + x1 * c.y; } }
        v4u o; o.x = cvt_pk_bf16(a[0], a[1]); o.y = cvt_pk_bf16(a[2], a[3]); o.z = cvt_pk_bf16(b[0], b[1]); o.w = cvt_pk_bf16(b[2], b[3]);
        *p = o;
    }
}

struct OnlineSm { float m, l, o0, o1; };
__device__ __forceinline__ void sm_key(OnlineSm& st, float q0, float q1, const bf16* krow, const bf16* vrow, int lane, float bias) {
    const unsigned kw = *(const unsigned*)(krow + 2 * lane);
    const float s = wave_sum(q0 * bf_lo(kw) + q1 * bf_hi(kw)) * ATT_SCALE + bias;
    const float mn = fmaxf(st.m, s), a = __expf(st.m - mn), p = __expf(s - mn);
    const unsigned vw = *(const unsigned*)(vrow + 2 * lane);
    st.l = st.l * a + p; st.o0 = st.o0 * a + p * bf_lo(vw); st.o1 = st.o1 * a + p * bf_hi(vw); st.m = mn;
}
__device__ __forceinline__ void attn_scalar(const Frame& F, const bf16* proj, bf16* ocat, const float* sink  , const float* rpb  ) {
    const int lane = F.lane;
    for (int it = F.gw; it < M * 20; it += F.ngw) {
        const int row = it / 20, sub = it - row * 20, b0 = row & ~(SEQ - 1), t = row & (SEQ - 1);
        const bf16* prow = proj + (size_t)row * NIN;
        OnlineSm st; st.m = -1e30f; st.l = 0.f; st.o0 = 0.f; st.o1 = 0.f; int ocol;
        if (sub < 8) {
            const int h = sub, kvh = h >> 2; ocol = OC_A + 128 * h;
            const unsigned qw = *(const unsigned*)(prow + OFF_QA + 128 * h + 2 * lane); const float q0 = bf_lo(qw), q1 = bf_hi(qw);
            st.m = sink[h]; st.l = 1.f;
            const int lo = t - 128 < 0 ? 0 : t - 128, hi = t + 128 > SEQ - 1 ? SEQ - 1 : t + 128;
            for (int tk = lo; tk <= hi; ++tk) { const bf16* kr = proj + (size_t)(b0 + tk) * NIN; sm_key(st, q0, q1, kr + OFF_KA + 128 * kvh, kr + OFF_VA + 128 * kvh, lane, 0.f); }
        } else if (sub < 12) {
            const int hg = sub - 8; ocol = OC_B + 128 * hg;
#pragma unroll 1
            for (int g = 0; g < 3; ++g) { const int dil = g == 0 ? 1 : (g == 1 ? 4 : 16), head = g * 4 + hg;
                const unsigned qw = *(const unsigned*)(prow + OFF_QB + 128 * head + 2 * lane); const float q0 = bf_lo(qw), q1 = bf_hi(qw);
                for (int dl = -64; dl <= 64; ++dl) { const int tk = t + dil * dl; if (tk < 0 || tk >= SEQ) continue;
                    const bf16* kr = proj + (size_t)(b0 + tk) * NIN; sm_key(st, q0, q1, kr + OFF_KB + 128 * head, kr + OFF_VB + 128 * head, lane, 0.f); } }
        } else {
            const int h = sub - 12; ocol = OC_C + 128 * h;
            const unsigned qw = *(const unsigned*)(prow + OFF_QC + 128 * h + 2 * lane); const float q0 = bf_lo(qw), q1 = bf_hi(qw);
            const int r = t >> 6, c = t & 63; int rs = r - 4; rs = rs < 0 ? 0 : (rs > 56 ? 56 : rs); int cs = c - 8; cs = cs < 0 ? 0 : (cs > 48 ? 48 : cs);
            for (int kr_ = rs; kr_ < rs + 8; ++kr_)
                for (int kc = cs; kc < cs + 16; ++kc) { int dc = kc - c; dc = dc < -15 ? -15 : (dc > 15 ? 15 : dc);
                    const float bias = rpb[(h * 15 + (kr_ - r + 7)) * 31 + dc + 15];
                    const bf16* kr = proj + (size_t)(b0 + kr_ * 64 + kc) * NIN; sm_key(st, q0, q1, kr + OFF_KC + 128 * h, kr + OFF_VC + 128 * h, lane, bias); }
        }
        const float inv = 1.0f / st.l;
        *(unsigned*)(ocat + (size_t)row * KBR + ocol + 2 * lane) = cvt_pk_bf16(st.o0 * inv, st.o1 * inv);
    }
}

#ifndef PHMASK
#define PHMASK 0xFFFF
#endif
#define PH_EN(k) ((PHMASK >> (k)) & 1)
#ifndef MK_SINGLE
#define MK_SINGLE 0
#endif
constexpr int NPH = 11;
constexpr int NPHASES = 1 + DEPTH * NPH;
__global__ void __launch_bounds__(NWAVES * 64, 2) mk_fwd(Args args) {
    extern __shared__ __attribute__((aligned(16))) unsigned char lds[];
    Frame F;
    F.lds = (LAS unsigned char*)lds;
    F.tid = threadIdx.x; F.lane = F.tid & 63; F.wave = __builtin_amdgcn_readfirstlane(F.tid >> 6); F.G = gridDim.x;
    F.gw = blockIdx.x * NWAVES + F.wave; F.ngw = F.G * NWAVES;
    F.ws = args.ws;
    volatile LAS unsigned* MISC = (volatile LAS unsigned*)(F.lds + MISC_OFF);
    if (F.tid < 32) MISC[F.tid] = 0u;
    __syncthreads();
    const int lo = args.ph_lo, hi = args.ph_hi; const bool multi = (hi - lo) > 1;
    XcdBarrier bar; bar.bar = (unsigned*)(F.ws + WS_CTL) + CW_BAR; bar.x = 0; bar.st = MISC + 8;
    if (multi) bar = xcd_barrier_post((unsigned*)(F.ws + WS_CTL) + CW_BAR, MISC + 8);
#define IN(k) (lo <= (k) && (k) < hi)
#define SEAM(k) do { if (IN((k) + 1)) xcd_barrier(bar); } while (0)

    if (PH_EN(0) && IN(0)) { p0_prologue(F, args); SEAM(0); }

#define XN ((bf16*)(wsb + WS_XN))
#define PROJ ((bf16*)(wsb + WS_PROJ))
#define HID ((bf16*)(wsb + WS_HID))
#define OCAT ((bf16*)(wsb + WS_OCAT))
#define MRG ((bf16*)(wsb + WS_MRG))
#define MACC ((float*)(wsb + WS_MACC))
#define WL(off) ((const bf16*)(wsb + WS_W + (size_t)layer * LW_SZ + (off)))
#define OPQ() unsigned char* wsb = args.ws; asm volatile("" : "+s"(wsb))
#pragma unroll 1
    for (int layer_ = 0; layer_ < DEPTH; ++layer_) {
        int layer = layer_; asm volatile("" : "+s"(layer));
        const int pb = 1 + layer * NPH;
        if (pb >= hi || pb + NPH <= lo) continue;

        if (PH_EN(1) && IN(pb + 0)) { OPQ(); rms_rows(F, layer == 0 ? args.in[0] : args.out, XN); SEAM(pb + 0); }
        if (PH_EN(2) && IN(pb + 1)) { OPQ(); pg8::Gemm g{XN, WL(LW_IN), DM, DM, M, NIN, DM}; pg8::StaticOrder S; S.init(M, NIN, F.G, (int)blockIdx.x); pg8::EpiProj E{PROJ};
            pg8::gemm_phase<pg8::EpiProj, pg8::StaticOrder, true, true>(F.lds + RING_OFF, g, S, E); SEAM(pb + 1); }
        if (PH_EN(3) && IN(pb + 2)) { OPQ(); qknorm_rope_rows(F, PROJ, args.in[3] + layer * 6 * HD); SEAM(pb + 2); }
        if (PH_EN(4) && IN(pb + 3)) { OPQ(); attn_scalar(F, PROJ, OCAT, args.in[4] + layer * 8, args.in[5] + layer * 8 * 15 * 31); SEAM(pb + 3); }
        if (PH_EN(5) && IN(pb + 4)) { OPQ(); pg8::Gemm g{OCAT + OC_A, WL(LW_BR), KBR, KBR, M, DM, 1024}; pg8::StaticOrder S; S.init(M, DM, F.G, (int)blockIdx.x); pg8::EpiGateAcc<0> E{PROJ + OFF_G, MACC, MRG};
            pg8::gemm_phase<pg8::EpiGateAcc<0>, pg8::StaticOrder, true, true>(F.lds + RING_OFF, g, S, E); SEAM(pb + 4); }
        if (PH_EN(6) && IN(pb + 5)) { OPQ(); pg8::Gemm g{OCAT + OC_B, WL(LW_BR) + 1024, KBR, KBR, M, DM, 512}; pg8::StaticOrder S; S.init(M, DM, F.G, (int)blockIdx.x); pg8::EpiGateAcc<1> E{PROJ + OFF_G + DM, MACC, MRG};
            pg8::gemm_phase<pg8::EpiGateAcc<1>, pg8::StaticOrder, true, true>(F.lds + RING_OFF, g, S, E); SEAM(pb + 5); }
        if (PH_EN(7) && IN(pb + 6)) { OPQ(); pg8::Gemm g{OCAT + OC_C, WL(LW_BR) + 1536, KBR, KBR, M, DM, 1024}; pg8::StaticOrder S; S.init(M, DM, F.G, (int)blockIdx.x); pg8::EpiGateAcc<2> E{PROJ + OFF_G + 2 * DM, MACC, MRG};
            pg8::gemm_phase<pg8::EpiGateAcc<2>, pg8::StaticOrder, true, true>(F.lds + RING_OFF, g, S, E); SEAM(pb + 6); }
        if (PH_EN(8) && IN(pb + 7)) { OPQ(); pg8::Gemm g{MRG, WL(LW_O), DM, DM, M, DM, DM}; pg8::StaticOrder S; S.init(M, DM, F.G, (int)blockIdx.x); pg8::EpiResF32 E{layer == 0 ? args.in[0] : args.out, args.out};
            pg8::gemm_phase<pg8::EpiResF32, pg8::StaticOrder, true, true>(F.lds + RING_OFF, g, S, E); SEAM(pb + 7); }
        if (PH_EN(9) && IN(pb + 8)) { OPQ(); rms_rows(F, args.out, XN); SEAM(pb + 8); }
        if (PH_EN(10) && IN(pb + 9)) { OPQ(); pg8::Gemm g{XN, WL(LW_GU), DM, DM, M, NGU, DM}; pg8::StaticOrder S; S.init(M, NGU, F.G, (int)blockIdx.x); pg8::EpiSwiglu E{HID};
            pg8::gemm_phase<pg8::EpiSwiglu, pg8::StaticOrder, true, true>(F.lds + RING_OFF, g, S, E); SEAM(pb + 9); }
        if (PH_EN(11) && IN(pb + 10)) { OPQ(); pg8::Gemm g{HID, WL(LW_D), DFF, DFF, M, DM, DFF}; pg8::StaticOrder S; S.init(M, DM, F.G, (int)blockIdx.x); pg8::EpiResF32 E{args.out, args.out};
            pg8::gemm_phase<pg8::EpiResF32, pg8::StaticOrder, true, true>(F.lds + RING_OFF, g, S, E); SEAM(pb + 10); }
    }
#undef IN
#undef SEAM
}

extern "C" void kernel_launch(void* const* d_in, const int* in_sizes, int n_in, void* d_out, int out_size, void* d_ws, size_t ws_size, hipStream_t stream) {
    static int grid = 0;
    if (grid == 0) {
        if (n_in != 13 || in_sizes[0] != M * DM || out_size != M * DM || ws_size < WS_END) { fprintf(stderr, "kernel_launch: unexpected shapes (n_in %d, in0 %d, out %d, ws %zu; need ws >= %zu); nothing launched\n", n_in, n_in > 0 ? in_sizes[0] : -1, out_size, ws_size, (size_t)WS_END); grid = -1; return; }
        int dev = 0, cus = 0, per_cu = 0;
        if (hipGetDevice(&dev) != hipSuccess || hipDeviceGetAttribute(&cus, hipDeviceAttributeMultiprocessorCount, dev) != hipSuccess) { grid = -1; return; }
        if (hipFuncSetAttribute((const void*)mk_fwd, hipFuncAttributeMaxDynamicSharedMemorySize, LDS_BYTES) != hipSuccess) { fprintf(stderr, "kernel_launch: hipFuncSetAttribute failed\n"); grid = -1; return; }
        if (hipOccupancyMaxActiveBlocksPerMultiprocessor(&per_cu, (const void*)mk_fwd, NWAVES * 64, LDS_BYTES) != hipSuccess || per_cu < 1) fprintf(stderr, "kernel_launch: occupancy query reports %d workgroups per CU\n", per_cu);
        (void)hipGetLastError();
        grid = cus;
    }
    if (grid < 0) return;
    if (hipMemsetAsync((char*)d_ws + WS_CTL, 0, CTL_ZERO_BYTES, stream) != hipSuccess) return;
    Args a{};
    for (int i = 0; i < 13; ++i) a.in[i] = (const float*)d_in[i];
    a.out = (float*)d_out; a.ws = (unsigned char*)d_ws;
    for (int i = 0; i < 64; ++i) a.inv_freq[i] = (float)pow(10000.0, -(double)(2 * i) / 128.0);
#if MK_SINGLE
    a.ph_lo = 0; a.ph_hi = NPHASES;
    hipLaunchKernelGGL(mk_fwd, dim3(grid), dim3(NWAVES * 64), LDS_BYTES, stream, a);
#else
    for (int p = 0; p < NPHASES; ++p) { a.ph_lo = p; a.ph_hi = p + 1; hipLaunchKernelGGL(mk_fwd, dim3(grid), dim3(NWAVES * 64), LDS_BYTES, stream, a); }
#endif
    const hipError_t le = hipPeekAtLastError();
    if (le != hipSuccess) fprintf(stderr, "kernel_launch: launch failed: %s\n", hipGetErrorName(le));
}
```

```cpp
#include <hip/hip_runtime.h>
#include <cstdio>
#include <cstdint>
#include <cmath>

constexpr int DM = 2048, NBATCH = 4, SEQ = 4096, M = NBATCH * SEQ, DEPTH = 4, HD = 128;
constexpr int NIN = 15360, DFF = 5632, NGU = 2 * DFF, KBR = 2560;
constexpr int OFF_QA = 0, OFF_KA = 1024, OFF_VA = 1280, OFF_QB = 1536, OFF_KB = 3072, OFF_VB = 4608, OFF_QC = 6144, OFF_KC = 7168, OFF_VC = 8192, OFF_G = 9216;
constexpr int OC_A = 0, OC_B = 1024, OC_C = 1536;
constexpr float NORM_EPS = 1e-6f;
constexpr float ATT_SCALE = 0.08838834764831845f;
constexpr int NWAVES = 8;

constexpr size_t MiB = 1u << 20;
constexpr size_t WS_CTL = 0, CTL_ZERO_BYTES = 65536;
constexpr size_t WS_ROPE = 1 * MiB;
constexpr size_t WS_W = 4 * MiB;
constexpr size_t LW_IN = 0, LW_BR = LW_IN + (size_t)NIN * DM * 2, LW_O = LW_BR + (size_t)DM * KBR * 2, LW_GU = LW_O + (size_t)DM * DM * 2,
                 LW_D = LW_GU + (size_t)NGU * DM * 2, LW_SZ = LW_D + (size_t)DM * DFF * 2;
static_assert(LW_SZ == 144 * MiB, "per-layer bf16 weights");
constexpr size_t WS_XN = WS_W + DEPTH * LW_SZ;
constexpr size_t WS_PROJ = WS_XN + (size_t)M * DM * 2;
constexpr size_t WS_HID = WS_PROJ;
constexpr size_t WS_OCAT = WS_PROJ + (size_t)M * NIN * 2;
constexpr size_t WS_MRG = WS_OCAT + (size_t)M * KBR * 2;
constexpr size_t WS_MACC = WS_MRG + (size_t)M * DM * 2;
constexpr size_t WS_OB = WS_MACC + (size_t)M * DM * 4;
constexpr size_t WS_LB = WS_OB + (size_t)3 * M * 512 * 2;
constexpr size_t WS_SSQ = WS_LB + (size_t)3 * M * 4 * 4;
constexpr size_t WS_XLO = WS_SSQ + (size_t)M * 8 * 4;
constexpr size_t WS_END = WS_XLO + (size_t)M * DM * 2;
constexpr int CW_SPLIT = 8192;
constexpr int CW_BAR = 4096;

constexpr int RING_OFF = 0, RING_BYTES = 131072;
constexpr int XCH_OFF = RING_BYTES, RS_OFF = RING_BYTES + 8192;
constexpr int MISC_OFF = RING_BYTES + 16384;
constexpr int LDS_BYTES = 151552;

#define GAS __attribute__((address_space(1)))
#define LAS __attribute__((address_space(3)))
typedef unsigned short bf16;
typedef unsigned v4u __attribute__((ext_vector_type(4)));
typedef unsigned v2u __attribute__((ext_vector_type(2)));
typedef float f32x4 __attribute__((ext_vector_type(4)));
typedef float f32x2 __attribute__((ext_vector_type(2)));
typedef short bf16x8 __attribute__((ext_vector_type(8)));
typedef _Float16 h16x2 __attribute__((ext_vector_type(2)));

__device__ __forceinline__ unsigned cvt_pk_bf16(float lo, float hi) { unsigned r; asm volatile("v_cvt_pk_bf16_f32 %0, %1, %2" : "=v"(r) : "v"(lo), "v"(hi)); return r; }
__device__ __forceinline__ unsigned cvt_pk_f16(float lo, float hi) { h16x2 h = {(_Float16)lo, (_Float16)hi}; return __builtin_bit_cast(unsigned, h); }
__device__ __forceinline__ float bf_lo(unsigned u) { return __uint_as_float(u << 16); }
__device__ __forceinline__ float bf_hi(unsigned u) { return __uint_as_float(u & 0xffff0000u); }
__device__ __forceinline__ float h_lo(unsigned u) { h16x2 h = __builtin_bit_cast(h16x2, u); return (float)h.x; }
__device__ __forceinline__ float h_hi(unsigned u) { h16x2 h = __builtin_bit_cast(h16x2, u); return (float)h.y; }
template <int CTRL> __device__ __forceinline__ float dpp_f(float v) { return __builtin_bit_cast(float, __builtin_amdgcn_update_dpp(0, __builtin_bit_cast(int, v), CTRL, 0xf, 0xf, true)); }
__device__ __forceinline__ float lane_xor1(float v) { return dpp_f<0xB1>(v); }
__device__ __forceinline__ float lane_xor2(float v) { return dpp_f<0x4E>(v); }
__device__ __forceinline__ float lane_xor16(float v) { return __builtin_bit_cast(float, __builtin_amdgcn_ds_swizzle(__builtin_bit_cast(int, v), (0x10 << 10) | 0x1f)); }
__device__ __forceinline__ float add_xor32(float v) { auto rr = __builtin_amdgcn_permlane32_swap(__float_as_uint(v), __float_as_uint(v), false, false); return __uint_as_float(rr[0]) + __uint_as_float(rr[1]); }
__device__ __forceinline__ float wave_sum(float v) {
    v += lane_xor1(v); v += lane_xor2(v); v += dpp_f<0x141>(v)  ; v += dpp_f<0x140>(v)  ; v += lane_xor16(v);
    return add_xor32(v);
}
__device__ __forceinline__ float sigmoidf_fast(float x) { return __builtin_amdgcn_rcpf(1.0f + __builtin_amdgcn_exp2f(-1.4426950408889634f * x)); }

__host__ __device__ inline int slot32_v(int c32) { return 16 * ((c32 >> 2) & 1) + 4 * (c32 >> 3) + (c32 & 3); }
__host__ __device__ inline int slot128_qk(int d) { const int n = d >> 6, dlo = d & 63; return 32 * (dlo >> 4) + 16 * n + 4 * ((dlo >> 2) & 3) + (dlo & 3); }
__host__ __device__ inline bool is_qk_col(int n) { return n < OFF_VA || (n >= OFF_QB && n < OFF_VB) || (n >= OFF_QC && n < OFF_VC); }
enum { MAP_NAT = 0, MAP_V = 1, MAP_IN = 2, MAP_GU = 3 };
template <int MAP> __host__ __device__ inline int map_row(int n) {
    if (MAP == MAP_NAT) return n;
    if (MAP == MAP_V) return (n & ~31) + slot32_v(n & 31);
    if (MAP == MAP_IN) return is_qk_col(n) ? (n & ~127) + slot128_qk(n & 127) : (n & ~31) + slot32_v(n & 31);
    const int up = n >= DFF ? 1 : 0, jh = n - up * DFF; return 256 * (jh >> 7) + 128 * up + (jh & 96) + slot32_v(jh & 31);
}
#define XB_TMO      128
#define XB_XCNT(j)  (256  + 64 * (j))
#define XB_XSUB(j)  (1280 + 64 * (j))
#define XB_XGEN(j)  (2304 + 64 * (j))
#define XB_TOP      3328
#define XB_TOPGEN   3392
#define XCD_BAR_WORDS 3456
#define XB_SPIN_CAP (1u << 18)

__device__ __forceinline__ unsigned xb_ld(unsigned* p)              { return __hip_atomic_load(p, __ATOMIC_RELAXED, __HIP_MEMORY_SCOPE_AGENT); }
__device__ __forceinline__ unsigned xb_add(unsigned* p, unsigned v) { return __hip_atomic_fetch_add(p, v, __ATOMIC_RELAXED, __HIP_MEMORY_SCOPE_AGENT); }
__device__ __forceinline__ unsigned xb_xcc_id() { return (unsigned)__builtin_amdgcn_s_getreg((3 << 11) | 20) & 0xFu; }
#define XB_SPIN(cond, bar) do { unsigned _sp = 0; while (cond) { __builtin_amdgcn_s_sleep(1); \
    if ((++_sp & 255u) == 0u) { if (xb_ld(&(bar)[XB_TMO])) break; if (_sp > XB_SPIN_CAP) { atomicAdd(&(bar)[XB_TMO], 1u); break; } } } } while (0)

struct XcdBarrier {
    unsigned* bar; unsigned x;
    volatile LAS unsigned* st;
};

__device__ __forceinline__ XcdBarrier xcd_barrier_post(unsigned* bar, volatile LAS unsigned* st) {
    XcdBarrier b; b.bar = bar; b.x = xb_xcc_id(); b.st = st;
    if (threadIdx.x == 0) (void)xb_add(&bar[XB_XCNT(b.x)], 1u);
    return b;
}
__device__ __forceinline__ void xcd_barrier_complete(unsigned* bar, unsigned x, unsigned& nloc, unsigned& nx) {
    const unsigned G = gridDim.x * gridDim.y * gridDim.z;
    unsigned sum, cnt, mine, sp = 0u;
    for (;;) {
        sum = 0u; cnt = 0u; mine = 0u;
#pragma unroll
        for (unsigned j = 0; j < 16; ++j) { const unsigned c = xb_ld(&bar[XB_XCNT(j)]); sum += c; cnt += (c > 0u) ? 1u : 0u; mine = (j == x) ? c : mine; }
        if (sum == G) break;
        __builtin_amdgcn_s_sleep(1);
        if ((++sp & 255u) == 0u) { if (xb_ld(&bar[XB_TMO])) break; if (sp > XB_SPIN_CAP) { atomicAdd(&bar[XB_TMO], 1u); break; } }
    }
    nloc = mine > 0u ? mine : 1u; nx = cnt > 0u ? cnt : 1u;
}

__device__ __forceinline__ void xcd_barrier(const XcdBarrier& b) {
    asm volatile("s_waitcnt vmcnt(0)" ::: "memory");
    __syncthreads();
    if (threadIdx.x == 0) {
        unsigned* bar; { __attribute__((address_space(1))) unsigned* bg_ = (__attribute__((address_space(1))) unsigned*)b.bar; asm volatile("" : "+s"(bg_)); bar = (unsigned*)bg_; }
        __builtin_amdgcn_s_waitcnt(0);
        unsigned bx = b.x; asm volatile("" : "+s"(bx));
        unsigned nloc = b.st[0], nx = b.st[1];
        if (nloc == 0u) { xcd_barrier_complete(bar, bx, nloc, nx); b.st[0] = nloc; b.st[1] = nx; }
        const unsigned old = xb_add(&bar[XB_XSUB(bx)], 1u);
        const unsigned gen = old / nloc;
        if (old + 1u == (gen + 1u) * nloc) {
            __builtin_amdgcn_fence(__ATOMIC_RELEASE, "agent");
            asm volatile("s_waitcnt vmcnt(0)" ::: "memory");
            const unsigned og = xb_add(&bar[XB_TOP], 1u);
            const unsigned tg = og / nx;
            if (og + 1u == (tg + 1u) * nx) xb_add(&bar[XB_TOPGEN], 1u);
            else XB_SPIN(xb_ld(&bar[XB_TOPGEN]) == tg, bar);
            __builtin_amdgcn_fence(__ATOMIC_ACQUIRE, "agent");
            xb_add(&bar[XB_XGEN(bx)], 1u);
            asm volatile("s_waitcnt vmcnt(0)" ::: "memory");
        } else {
            XB_SPIN(xb_ld(&bar[XB_XGEN(bx)]) == gen, bar);
            __builtin_amdgcn_fence(__ATOMIC_ACQUIRE, "agent");
            asm volatile("s_waitcnt vmcnt(0)" ::: "memory");
        }
    }
    __syncthreads();
}

__device__ __forceinline__ void xcd_split_arrive(const XcdBarrier& b, unsigned* cb) {
    asm volatile("s_waitcnt vmcnt(0)" ::: "memory");
    __syncthreads();
    if (threadIdx.x == 0) {
        __attribute__((address_space(1))) unsigned* cg_ = (__attribute__((address_space(1))) unsigned*)cb; asm volatile("" : "+s"(cg_)); unsigned* c = (unsigned*)cg_;
        unsigned bx = b.x; asm volatile("" : "+s"(bx));
        const unsigned nloc = b.st[0];
        const unsigned old = xb_add(&c[64u * bx], 1u);
        if (old + 1u == nloc) {
            __builtin_amdgcn_fence(__ATOMIC_RELEASE, "agent");
            asm volatile("s_waitcnt vmcnt(0)" ::: "memory");
            xb_add(&c[1024], 1u);
        }
    }
}
__device__ __forceinline__ void xcd_split_wait_t0(unsigned* cb, unsigned nx, unsigned* tmo) {
    __attribute__((address_space(1))) unsigned* cg_ = (__attribute__((address_space(1))) unsigned*)cb; asm volatile("" : "+s"(cg_)); unsigned* c = (unsigned*)cg_;
    XB_SPIN(xb_ld(&c[1024]) < nx, tmo);
    __builtin_amdgcn_fence(__ATOMIC_ACQUIRE, "agent");
    asm volatile("s_waitcnt vmcnt(0)" ::: "memory");
}
namespace pg8 {
#define PG8_LAS __attribute__((address_space(3)))
typedef unsigned short bf16_t;
constexpr int BM = 256, BK = 64, HALF = 128, HTB = HALF * BK * 2  , STAGE_BYTES = 8 * HTB, NXCD = 8, WGM = 8;
__host__ __device__ __forceinline__ int lds_byte(int r, int c) { const int st = (r >> 4) * 2 + (c >> 5), rr = r & 15, cc = c & 31, ob = rr * 64 + cc * 2; return st * 1024 + (ob ^ (((ob >> 9) & 1) << 5)); }
__host__ __device__ __forceinline__ void stage_rc(int b, int& R, int& C) { const int st = b / 1024, sb = b % 1024, swz = sb ^ (((sb >> 9) & 1) << 5); R = (st >> 1) * 16 + swz / 64; C = (st & 1) * 32 + (swz % 64) / 2; }
struct Unit { int pm, pn; };
struct Gemm { const bf16_t* A; const bf16_t* Bt; int lda, ldb, M, N, K; };
struct StaticOrder {
    int nM, nN, nwg, G, c;
    __host__ __device__ __forceinline__ void init(int M, int N, int G_, int c_) { nM = M / BM; nN = N / BM; nwg = nM * nN; G = G_; c = c_; }
    __host__ __device__ __forceinline__ bool next(int i, Unit& u) const {
        const long L = (long)i * G + c; if (L >= nwg) return false;
        int wgid = (int)L; { const int q = nwg / NXCD, r = nwg % NXCD, xcd = wgid % NXCD, off = wgid / NXCD; wgid = (xcd < r ? xcd * (q + 1) : r * (q + 1) + (xcd - r) * q) + off; }
        const int nig = WGM * nN, gid = wgid / nig, fm = gid * WGM, gsz = (nM - fm) < WGM ? (nM - fm) : WGM;
        u.pm = fm + ((wgid % nig) % gsz); u.pn = (wgid % nig) / gsz; return true;
    }
    __device__ __forceinline__ void a_ready(const Unit&) const {}
    __device__ __forceinline__ void done(const Unit&) const {}
};
template <class Epi, class Sched, bool ALIGN_EPI = false, bool SP2 = false>
__device__ __forceinline__ void gemm_phase(PG8_LAS unsigned char* lds, const Gemm g, const Sched& S, const Epi& E) {
    int tid = threadIdx.x; asm volatile("" : "+v"(tid));
    const int wid = __builtin_amdgcn_readfirstlane(tid >> 6), lane = tid & 63, wr = wid >> 2, wc = wid & 3, fr = lane & 15, fq = lane >> 4;
    const int K = g.K, nt = K / BK, lda = g.lda, ldb = g.ldb;
    unsigned voffA[2], voffB[2];
#pragma unroll
    for (int i = 0; i < 2; ++i) { int R, C; stage_rc(tid * 16 + i * 8192, R, C);
        voffA[i] = (unsigned)(R * lda + C) * 2u; voffB[i] = (unsigned)(R * ldb + C) * 2u; }
    const size_t kstep = (size_t)(BK * 2);
    const size_t hstepA = (size_t)HALF * lda * 2, hstepB = (size_t)HALF * ldb * 2;
    const size_t tstepA = 2 * hstepA, tstepB = 2 * hstepB;
    const unsigned ldsw = (unsigned)wid * 1024u;
    const int aoff = lds_byte(wr * 64 + fr, fq * 8), boff = lds_byte(wc * 32 + fr, fq * 8);
#define PG8_SA(b, h) (((b) * 2 + (h)) * HTB)
#define PG8_SB(b, h) ((4 + (b) * 2 + (h)) * HTB)
#define PG8_STAGE(bufoff, gbase, voff) do { _Pragma("unroll") for (int _i = 0; _i < 2; ++_i) \
        __builtin_amdgcn_global_load_lds((const unsigned*)((const char*)(gbase) + (voff)[_i]), (PG8_LAS unsigned*)(lds + (bufoff) + ldsw + _i * 8192), 16, 0, 0); } while (0)
#define PG8_LDA(dst, b, h) do { _Pragma("unroll") for (int m = 0; m < 4; ++m) _Pragma("unroll") for (int k = 0; k < 2; ++k) dst[m][k] = *(const PG8_LAS bf16x8*)(lds + PG8_SA(b, h) + aoff + m * 2048 + k * 1024); } while (0)
#define PG8_LDB(dst, b, h) do { _Pragma("unroll") for (int n = 0; n < 2; ++n) _Pragma("unroll") for (int k = 0; k < 2; ++k) dst[n][k] = *(const PG8_LAS bf16x8*)(lds + PG8_SB(b, h) + boff + n * 2048 + k * 1024); } while (0)
#define PG8_MMA(ai, bj, At, Bt) do { __builtin_amdgcn_s_setprio(1); _Pragma("unroll") for (int m = 0; m < 4; ++m) _Pragma("unroll") for (int n = 0; n < 2; ++n) _Pragma("unroll") for (int k = 0; k < 2; ++k) \
        acc[ai][bj][m][n] = __builtin_amdgcn_mfma_f32_16x16x32_bf16(Bt[n][k], At[m][k], acc[ai][bj][m][n], 0, 0, 0); __builtin_amdgcn_s_setprio(0); } while (0)
#define PG8_WAIT_V(n) asm volatile("s_waitcnt vmcnt(" #n ")" ::: "memory")
#define PG8_WAIT_L(n) asm volatile("s_waitcnt lgkmcnt(" #n ")" ::: "memory")
#define PG8_BAR __builtin_amdgcn_s_barrier()
#define PG8_SCHED __builtin_amdgcn_sched_barrier(0)
    Unit cur, nxt; int ui = 0;
    if (!S.next(0, cur)) return;
    f32x4 acc[2][2][4][2];
#pragma unroll
    for (int a = 0; a < 2; ++a)
#pragma unroll
        for (int b = 0; b < 2; ++b)
#pragma unroll
            for (int m = 0; m < 4; ++m)
#pragma unroll
                for (int n = 0; n < 2; ++n) acc[a][b][m][n] = (f32x4){0.f, 0.f, 0.f, 0.f};
    bf16x8 At[4][2], B0[2][2], B1[2][2];
    int k0 = 0; if constexpr (Epi::KPERM) k0 = E.seg_first(0) * (int)(BK * 2);
    const char* cA = (const char*)g.A + (size_t)cur.pm * tstepA + k0; const char* cB = (const char*)g.Bt + (size_t)cur.pn * tstepB + k0;
    S.a_ready(cur);
    if constexpr (SP2) {
        PG8_STAGE(PG8_SB(0, 0), cB, voffB); PG8_STAGE(PG8_SB(0, 1), cB + hstepB, voffB); PG8_STAGE(PG8_SA(0, 0), cA, voffA); PG8_STAGE(PG8_SA(0, 1), cA + hstepA, voffA);
        if (wr == 1) PG8_BAR;
        PG8_WAIT_V(2); PG8_BAR;
        E.pro();
        PG8_STAGE(PG8_SB(1, 0), cB + kstep, voffB); PG8_STAGE(PG8_SA(1, 0), cA + kstep, voffA); PG8_STAGE(PG8_SB(1, 1), cB + hstepB + kstep, voffB);
        PG8_WAIT_V(6); PG8_BAR;
    } else {
        PG8_STAGE(PG8_SB(0, 0), cB, voffB); PG8_STAGE(PG8_SA(0, 0), cA, voffA); PG8_STAGE(PG8_SB(0, 1), cB + hstepB, voffB); PG8_STAGE(PG8_SA(0, 1), cA + hstepA, voffA);
        if (wr == 1) PG8_BAR;
        PG8_WAIT_V(4); PG8_BAR;
        PG8_STAGE(PG8_SB(1, 0), cB + kstep, voffB); PG8_STAGE(PG8_SA(1, 0), cA + kstep, voffA); PG8_STAGE(PG8_SB(1, 1), cB + hstepB + kstep, voffB);
        PG8_WAIT_V(6); PG8_BAR;
    }
    for (;;) {
        const bool has_next = S.next(ui + 1, nxt);
        const char* nA = has_next ? (const char*)g.A + (size_t)nxt.pm * tstepA + k0 : cA; const char* nB = has_next ? (const char*)g.Bt + (size_t)nxt.pn * tstepB + k0 : cB;
#pragma unroll
        for (int sg = 0; sg < Epi::NSEG; ++sg) {
        int t_lo, t_hi, dk = 0, dkn = 0;
        if constexpr (Epi::KPERM) { t_lo = sg == 0 ? 0 : E.seg_end(sg - 1); t_hi = sg == Epi::NSEG - 1 ? nt : E.seg_end(sg);
            dk = (E.seg_first(sg) - t_lo) * (int)(BK * 2) - k0; if (sg + 1 < Epi::NSEG) dkn = (E.seg_first(sg + 1) - t_hi) * (int)(BK * 2) - k0; }
        else { t_lo = sg == 0 ? 0 : Epi::SEG_END[sg - 1]; t_hi = sg == Epi::NSEG - 1 ? nt : Epi::SEG_END[sg]; }
        for (int t = t_lo; t < t_hi; t += 2) {
            const bool last = (t == nt - 2);
            const int d2 = (t + 2 == t_hi) ? dkn : dk;
            const char* a1 = cA + (long)((t + 1) * (int)(BK * 2) + dk);
            const char* a2 = last ? nA : cA + (long)((t + 2) * (int)(BK * 2) + d2); const char* b2 = last ? nB : cB + (long)((t + 2) * (int)(BK * 2) + d2);
            const char* a3 = a2 + kstep; const char* b3 = b2 + kstep;
            if (last && has_next) S.a_ready(nxt);
            if constexpr (SP2) {
            PG8_LDB(B0, 0, 0); PG8_LDB(B1, 0, 1); PG8_SCHED; PG8_LDA(At, 0, 0); PG8_STAGE(PG8_SA(1, 1), a1 + hstepA, voffA);
            PG8_WAIT_V(8); PG8_WAIT_L(0); PG8_BAR; PG8_MMA(0, 0, At, B0); PG8_MMA(0, 1, At, B1); PG8_BAR; PG8_SCHED;
            PG8_LDA(At, 0, 1); PG8_STAGE(PG8_SB(0, 0), b2, voffB); PG8_STAGE(PG8_SB(0, 1), b2 + hstepB, voffB); PG8_STAGE(PG8_SA(0, 0), a2, voffA);
            PG8_WAIT_V(8); PG8_WAIT_L(0); PG8_BAR; PG8_MMA(1, 0, At, B0); PG8_MMA(1, 1, At, B1); PG8_BAR; PG8_SCHED;
            PG8_LDB(B0, 1, 0); PG8_LDB(B1, 1, 1); PG8_SCHED; PG8_LDA(At, 1, 0); PG8_STAGE(PG8_SA(0, 1), a2 + hstepA, voffA);
            PG8_WAIT_V(8); PG8_WAIT_L(0); PG8_BAR; PG8_MMA(0, 0, At, B0); PG8_MMA(0, 1, At, B1); PG8_BAR; PG8_SCHED;
            PG8_LDA(At, 1, 1); PG8_STAGE(PG8_SB(1, 0), b3, voffB); PG8_STAGE(PG8_SB(1, 1), b3 + hstepB, voffB); PG8_STAGE(PG8_SA(1, 0), a3, voffA);
            PG8_WAIT_V(8); PG8_WAIT_L(0); PG8_BAR; PG8_MMA(1, 0, At, B0); PG8_MMA(1, 1, At, B1); PG8_BAR; PG8_SCHED;
            } else {
            PG8_LDB(B0, 0, 0); PG8_SCHED; PG8_LDA(At, 0, 0); PG8_STAGE(PG8_SA(1, 1), a1 + hstepA, voffA);
            PG8_WAIT_L(8); PG8_BAR; PG8_WAIT_L(0); PG8_MMA(0, 0, At, B0); PG8_BAR; PG8_SCHED;
            PG8_LDB(B1, 0, 1); PG8_STAGE(PG8_SB(0, 0), b2, voffB);
            PG8_BAR; PG8_WAIT_L(0); PG8_MMA(0, 1, At, B1); PG8_BAR;
            PG8_LDA(At, 0, 1); PG8_STAGE(PG8_SA(0, 0), a2, voffA);
            PG8_BAR; PG8_WAIT_L(0); PG8_MMA(1, 0, At, B0); PG8_BAR; PG8_SCHED;
            PG8_STAGE(PG8_SB(0, 1), b2 + hstepB, voffB);
            PG8_WAIT_V(6); PG8_BAR; PG8_MMA(1, 1, At, B1); PG8_BAR;
            PG8_LDB(B0, 1, 0); PG8_SCHED; PG8_LDA(At, 1, 0); PG8_STAGE(PG8_SA(0, 1), a2 + hstepA, voffA);
            PG8_WAIT_L(8); PG8_BAR; PG8_WAIT_L(0); PG8_MMA(0, 0, At, B0); PG8_BAR; PG8_SCHED;
            PG8_LDB(B1, 1, 1); PG8_STAGE(PG8_SB(1, 0), b3, voffB);
            PG8_BAR; PG8_WAIT_L(0); PG8_MMA(0, 1, At, B1); PG8_BAR;
            PG8_LDA(At, 1, 1); PG8_STAGE(PG8_SA(1, 0), a3, voffA);
            PG8_BAR; PG8_WAIT_L(0); PG8_MMA(1, 0, At, B0); PG8_BAR; PG8_SCHED;
            PG8_STAGE(PG8_SB(1, 1), b3 + hstepB, voffB);
            PG8_WAIT_V(6); PG8_BAR; PG8_MMA(1, 1, At, B1); PG8_BAR;
            }
        }
        if constexpr (Epi::NSEG > 1) { if (sg + 1 < Epi::NSEG) E.mid(acc, cur, sg, wr, wc, fr, fq); }
        }
        if constexpr (ALIGN_EPI) { if (wr == 0) PG8_BAR; }
        if constexpr (!Epi::AFTER_DRAIN) { E(acc, cur, wr, wc, fr, fq); S.done(cur); }
        if (!has_next) break;
#pragma unroll
        for (int a = 0; a < 2; ++a)
#pragma unroll
            for (int b = 0; b < 2; ++b)
#pragma unroll
                for (int m = 0; m < 4; ++m)
#pragma unroll
                    for (int n = 0; n < 2; ++n) { f32x2 z0_, z1_; asm("v_mov_b64 %0, 0" : "=v"(z0_)); asm("v_mov_b64 %0, 0" : "=v"(z1_)); acc[a][b][m][n] = (f32x4){z0_[0], z0_[1], z1_[0], z1_[1]}; }
        cur = nxt; cA = nA; cB = nB; ++ui;
        if constexpr (ALIGN_EPI) { if (wr == 1) PG8_BAR; }
    }
    PG8_WAIT_V(0);
    if constexpr (!ALIGN_EPI) { if (wr == 0) PG8_BAR; }
    PG8_BAR;
    if constexpr (Epi::AFTER_DRAIN) { E.fused(acc, cur, wr, wc, fr, fq, lds, wid, lane); S.done(cur); }
#undef PG8_SA
#undef PG8_SB
#undef PG8_STAGE
#undef PG8_LDA
#undef PG8_LDB
#undef PG8_MMA
#undef PG8_WAIT_V
#undef PG8_WAIT_L
#undef PG8_BAR
#undef PG8_SCHED
}
}
namespace pg8 {
constexpr size_t PROJ_GATE0 = (size_t)72 * M * 128;
__device__ __forceinline__ size_t proj_qkv_off(int hh, int row) { return ((size_t)hh * M + row) * 128; }
__device__ __forceinline__ size_t proj_gate_off(int pnp, int pm, int row_local, int col_local) { return PROJ_GATE0 + ((size_t)(pnp * (M / BM) + pm) * BM + row_local) * BM + col_local; }
__device__ __forceinline__ float gate_val(float x) { return fminf(__builtin_amdgcn_exp2f(-1.4426950408889634f * x), 65504.0f); }
struct EpiProj {
    static constexpr bool AFTER_DRAIN = false; static constexpr bool KPERM = false; static constexpr int NSEG = 1; static constexpr int SEG_END[1] = {0};
    __device__ __forceinline__ void pro() const {
#pragma unroll
        for (int i = 0; i < 4; ++i) { const f32x4 s0 = rsv[i][0], s1 = rsv[i][1];
            ((PG8_LAS float*)RS)[threadIdx.x + i * 512] = __builtin_amdgcn_rsqf((((s0[0] + s0[1]) + (s0[2] + s0[3])) + ((s1[0] + s1[1]) + (s1[2] + s1[3]))) * (1.0f / DM) + NORM_EPS); }
    }
    bf16_t* P; const float* qkg  ; const unsigned* rope  ; PG8_LAS float* X  ;
    const PG8_LAS float* RS  ;
    f32x4 rsv[4][2];
    __device__ __forceinline__ void operator()(const f32x4 (&acc)[2][2][4][2], const Unit& u, int wr, int wc, int fr, int fq) const {
        int row0 = u.pm * BM + wr * 64 + fr, col0 = u.pn * BM + wc * 32 + 8 * fq; const int pn = u.pn;
        asm volatile("" : "+v"(row0), "+v"(col0));
        const bool gate = pn >= OFF_G / BM;
        const bool qk = pn < 5 || (pn >= 6 && pn < 18) || (pn >= 24 && pn < 32);
        float rsx[2][4];
#pragma unroll
        for (int ai = 0; ai < 2; ++ai)
#pragma unroll
            for (int m = 0; m < 4; ++m) rsx[ai][m] = RS[(u.pm & 7) * BM + ai * HALF + wr * 64 + m * 16 + fr];
        if (qk) {
            const int gi = pn < 4 ? 0 : (pn == 4 ? 1 : (pn < 12 ? 2 : (pn < 18 ? 3 : (pn < 28 ? 4 : 5))));
#pragma unroll
            for (int ai = 0; ai < 2; ++ai)
#pragma unroll
                for (int m = 0; m < 4; ++m)
#pragma unroll
                    for (int bj = 0; bj < 2; ++bj) { const f32x4 v0 = acc[ai][bj][m][0] * rsx[ai][m], v1 = acc[ai][bj][m][1] * rsx[ai][m];
                        float s = (v0[0] * v0[0] + v0[1] * v0[1]) + (v0[2] * v0[2] + v0[3] * v0[3]) + (v1[0] * v1[0] + v1[1] * v1[1]) + (v1[2] * v1[2] + v1[3] * v1[3]);
                        s += lane_xor16(s); s = add_xor32(s);
                        if (fq == 0) X[(ai * HALF + wr * 64 + m * 16 + fr) * 8 + bj * 4 + wc] = s; }
            const f32x4 ga = *(const f32x4*)(qkg + gi * HD + 16 * wc + 4 * fq), gb = *(const f32x4*)(qkg + gi * HD + 64 + 16 * wc + 4 * fq);
            v4u rc[2][4];
            if (gi < 4) {
#pragma unroll
                for (int ai = 0; ai < 2; ++ai)
#pragma unroll
                    for (int m = 0; m < 4; ++m) { const int r = row0 + ai * HALF + m * 16; rc[ai][m] = *(const v4u*)(rope + (size_t)(r & (SEQ - 1)) * 64 + 16 * wc + 4 * fq); }
            }
            asm volatile("s_waitcnt lgkmcnt(0)" ::: "memory"); __builtin_amdgcn_s_barrier(); asm volatile("" ::: "memory");
#pragma unroll
            for (int ai = 0; ai < 2; ++ai)
#pragma unroll
                for (int m = 0; m < 4; ++m) { const int r = row0 + ai * HALF + m * 16; bf16_t* rowp = P + proj_qkv_off(2 * pn, r) + (col0 & 255);
                    f32x2 cs[4];
                    if (gi < 4) { const v4u c = rc[ai][m];
                        cs[0] = (f32x2){h_lo(c.x), h_hi(c.x)}; cs[1] = (f32x2){h_lo(c.y), h_hi(c.y)}; cs[2] = (f32x2){h_lo(c.z), h_hi(c.z)}; cs[3] = (f32x2){h_lo(c.w), h_hi(c.w)}; }
#pragma unroll
                    for (int bj = 0; bj < 2; ++bj) { const f32x4 t = *(const PG8_LAS f32x4*)(X + (ai * HALF + wr * 64 + m * 16 + fr) * 8 + bj * 4);
                        const float rs = rsx[ai][m] * __builtin_amdgcn_rsqf(((t[0] + t[1]) + (t[2] + t[3])) * (1.0f / HD) + NORM_EPS);
                        f32x4 a = acc[ai][bj][m][0] * rs * ga, b = acc[ai][bj][m][1] * rs * gb;
                        if (gi < 4) {
#pragma unroll
                            for (int j = 0; j < 4; ++j) { const float x1 = a[j], x2 = b[j]; a[j] = x1 * cs[j].x - x2 * cs[j].y; b[j] = x2 * cs[j].x + x1 * cs[j].y; } }
                        v4u w; w.x = cvt_pk_bf16(a[0], a[1]); w.y = cvt_pk_bf16(a[2], a[3]); w.z = cvt_pk_bf16(b[0], b[1]); w.w = cvt_pk_bf16(b[2], b[3]);
                        *(v4u*)(rowp + (size_t)bj * M * 128) = w; } }
            return;
        }
        if (gate) {
#pragma unroll
            for (int ai = 0; ai < 2; ++ai)
#pragma unroll
                for (int m = 0; m < 4; ++m) { const int rg_ = row0 + ai * HALF + m * 16, cl_ = col0 & 255; bf16_t* rowp = P + proj_gate_off(pn - OFF_G / BM, u.pm, rg_ & 255, cl_);
#pragma unroll
                    for (int bj = 0; bj < 2; ++bj) { const f32x4 v0 = acc[ai][bj][m][0] * rsx[ai][m], v1 = acc[ai][bj][m][1] * rsx[ai][m]; v4u w;
                        w.x = cvt_pk_f16(gate_val(v0[0]), gate_val(v0[1])); w.y = cvt_pk_f16(gate_val(v0[2]), gate_val(v0[3]));
                        w.z = cvt_pk_f16(gate_val(v1[0]), gate_val(v1[1])); w.w = cvt_pk_f16(gate_val(v1[2]), gate_val(v1[3]));
                        *(v4u*)(rowp + bj * HALF) = w; } }
            return;
        }
#pragma unroll
        for (int ai = 0; ai < 2; ++ai)
#pragma unroll
            for (int m = 0; m < 4; ++m) { const int rg_ = row0 + ai * HALF + m * 16, cl_ = col0 & 255; bf16_t* rowp = P + proj_qkv_off(2 * pn, rg_) + cl_;
#pragma unroll
                for (int bj = 0; bj < 2; ++bj) { const f32x4 v0 = acc[ai][bj][m][0] * rsx[ai][m], v1 = acc[ai][bj][m][1] * rsx[ai][m]; v4u w;
                    w.x = cvt_pk_bf16(v0[0], v0[1]); w.y = cvt_pk_bf16(v0[2], v0[3]); w.z = cvt_pk_bf16(v1[0], v1[1]); w.w = cvt_pk_bf16(v1[2], v1[3]);
                    *(v4u*)(rowp + (size_t)bj * M * 128) = w; } }
    }
};
template <int MODE> struct EpiGateAcc {
    static constexpr bool AFTER_DRAIN = false; static constexpr bool KPERM = false; static constexpr int NSEG = 1; static constexpr int SEG_END[1] = {0};
    __device__ __forceinline__ void pro() const {}
    const bf16_t* G; float* macc; bf16_t* mrg;
    __device__ __forceinline__ void operator()(const f32x4 (&acc)[2][2][4][2], const Unit& u, int wr, int wc, int fr, int fq) const {
        const int row0 = u.pm * BM + wr * 64 + fr, col0 = u.pn * BM + wc * 32 + 8 * fq;
#pragma unroll
        for (int ai = 0; ai < 2; ++ai)
#pragma unroll
            for (int m = 0; m < 4; ++m) { const int r = row0 + ai * HALF + m * 16;
#pragma unroll
                for (int bj = 0; bj < 2; ++bj) { const int c = col0 + bj * HALF;
                    const v4u gw = *(const v4u*)(G + (size_t)r * NIN + c);
                    f32x4 a0 = acc[ai][bj][m][0], a1 = acc[ai][bj][m][1];
                    a0[0] *= h_lo(gw.x); a0[1] *= h_hi(gw.x); a0[2] *= h_lo(gw.y); a0[3] *= h_hi(gw.y);
                    a1[0] *= h_lo(gw.z); a1[1] *= h_hi(gw.z); a1[2] *= h_lo(gw.w); a1[3] *= h_hi(gw.w);
                    float* mp = macc + (size_t)r * DM + c;
                    if (MODE >= 1) { a0 += *(const f32x4*)mp; a1 += *(const f32x4*)(mp + 4); }
                    if (MODE <= 1) { *(f32x4*)mp = a0; *(f32x4*)(mp + 4) = a1; }
                    else { v4u w; w.x = cvt_pk_bf16(a0[0], a0[1]); w.y = cvt_pk_bf16(a0[2], a0[3]); w.z = cvt_pk_bf16(a1[0], a1[1]); w.w = cvt_pk_bf16(a1[2], a1[3]);
                           *(v4u*)(mrg + (size_t)r * DM + c) = w; } } }
    }
};
struct EpiResNorm {
    static constexpr bool AFTER_DRAIN = false; static constexpr bool KPERM = false; static constexpr int NSEG = 1; static constexpr int SEG_END[1] = {0};
    __device__ __forceinline__ void pro() const {}
    float* out_f32; bf16_t* hi; float* SSQ; PG8_LAS float* X;
    __device__ __forceinline__ void operator()(const f32x4 (&acc)[2][2][4][2], const Unit& u, int wr, int wc, int fr, int fq) const {
        const int row0 = u.pm * BM + wr * 64 + fr, col0 = u.pn * BM + wc * 32 + 8 * fq;
        v4u bv[2][4][2];
#pragma unroll
        for (int ai = 0; ai < 2; ++ai)
#pragma unroll
            for (int m = 0; m < 4; ++m)
#pragma unroll
                for (int bj = 0; bj < 2; ++bj) bv[ai][m][bj] = *(const v4u*)(hi + (size_t)(row0 + ai * HALF + m * 16) * DM + col0 + bj * HALF);
#pragma unroll
        for (int ai = 0; ai < 2; ++ai) {
#pragma unroll
            for (int m = 0; m < 4; ++m) { const size_t off = (size_t)(row0 + ai * HALF + m * 16) * DM + col0; float s = 0.f;
#pragma unroll
                for (int bj = 0; bj < 2; ++bj) { const v4u p = bv[ai][m][bj];
                    const f32x4 b0 = (f32x4){bf_lo(p.x), bf_hi(p.x), bf_lo(p.y), bf_hi(p.y)}, b1 = (f32x4){bf_lo(p.z), bf_hi(p.z), bf_lo(p.w), bf_hi(p.w)};
                    const f32x4 o0 = b0 + acc[ai][bj][m][0], o1 = b1 + acc[ai][bj][m][1];
                    if (out_f32) { *(f32x4*)(out_f32 + off + bj * HALF) = o0; *(f32x4*)(out_f32 + off + bj * HALF + 4) = o1; }
                    else { v4u h; h.x = cvt_pk_bf16(o0[0], o0[1]); h.y = cvt_pk_bf16(o0[2], o0[3]); h.z = cvt_pk_bf16(o1[0], o1[1]); h.w = cvt_pk_bf16(o1[2], o1[3]);
                        *(v4u*)(hi + off + bj * HALF) = h; }
                    s += ((o0[0] * o0[0] + o0[1] * o0[1]) + (o0[2] * o0[2] + o0[3] * o0[3])) + ((o1[0] * o1[0] + o1[1] * o1[1]) + (o1[2] * o1[2] + o1[3] * o1[3])); }
                s += lane_xor16(s); s = add_xor32(s);
                if (fq == 0) X[(ai * HALF + wr * 64 + m * 16 + fr) * 4 + wc] = s; }
            asm volatile("" ::: "memory");
        }
        asm volatile("s_waitcnt lgkmcnt(0)" ::: "memory"); __builtin_amdgcn_s_barrier(); asm volatile("" ::: "memory");
        const int t = threadIdx.x;
        if (t < BM) { const f32x4 p = *(const PG8_LAS f32x4*)(X + t * 4); SSQ[(size_t)(u.pm * BM + t) * 8 + u.pn] = (p[0] + p[1]) + (p[2] + p[3]); }
    }
};
struct EpiSwiglu {
    static constexpr bool AFTER_DRAIN = false; static constexpr bool KPERM = false; static constexpr int NSEG = 1; static constexpr int SEG_END[1] = {0};
    __device__ __forceinline__ void pro() const {
#pragma unroll
        for (int i = 0; i < 4; ++i) { const f32x4 s0 = rsv[i][0], s1 = rsv[i][1];
            ((PG8_LAS float*)RS)[threadIdx.x + i * 512] = __builtin_amdgcn_rsqf((((s0[0] + s0[1]) + (s0[2] + s0[3])) + ((s1[0] + s1[1]) + (s1[2] + s1[3]))) * (1.0f / DM) + NORM_EPS); }
    }
    bf16_t* H; const PG8_LAS float* RS;
    f32x4 rsv[4][2];
    __device__ __forceinline__ void operator()(const f32x4 (&acc)[2][2][4][2], const Unit& u, int wr, int wc, int fr, int fq) const {
        const int row0 = u.pm * BM + wr * 64 + fr, col0 = u.pn * HALF + wc * 32 + 8 * fq;
        float rsx[2][4];
#pragma unroll
        for (int ai = 0; ai < 2; ++ai)
#pragma unroll
            for (int m = 0; m < 4; ++m) rsx[ai][m] = RS[(u.pm & 7) * BM + ai * HALF + wr * 64 + m * 16 + fr];
#pragma unroll
        for (int ai = 0; ai < 2; ++ai)
#pragma unroll
            for (int m = 0; m < 4; ++m) { float h[8]; const float rs = rsx[ai][m];
#pragma unroll
                for (int n = 0; n < 2; ++n)
#pragma unroll
                    for (int j = 0; j < 4; ++j) { const float g = acc[ai][0][m][n][j] * rs, up = acc[ai][1][m][n][j] * rs; h[4 * n + j] = g * sigmoidf_fast(g) * up; }
                v4u w; w.x = cvt_pk_bf16(h[0], h[1]); w.y = cvt_pk_bf16(h[2], h[3]); w.z = cvt_pk_bf16(h[4], h[5]); w.w = cvt_pk_bf16(h[6], h[7]);
                *(v4u*)(H + (size_t)(row0 + ai * HALF + m * 16) * DFF + col0) = w; }
    }
};
struct EpiBranch {
    static constexpr bool AFTER_DRAIN = false; static constexpr bool KPERM = true; static constexpr int NSEG = 3; static constexpr int SEG_END[3] = {16, 32, KBR / BK};
    __device__ __forceinline__ void pro() const {}
    unsigned char* ws; int layer; volatile PG8_LAS unsigned* st;
    __device__ __forceinline__ const bf16_t* Gp() const { return (const bf16_t*)(ws + WS_PROJ); }
    __device__ __forceinline__ bf16_t* mrgp() const { return (bf16_t*)(ws + WS_MRG); }
    __device__ __forceinline__ int seg_end(int sg) const { return sg == 0 ? 16 : (sg == 1 ? 32 : 40); }
    __device__ __forceinline__ int seg_first(int sg) const { return sg == 0 ? 0 : (sg == 1 ? 24 : 16); }
    __device__ __forceinline__ void mid(f32x4 (&acc)[2][2][4][2], const Unit& u, int which, int wr, int wc, int fr, int fq) const {
        if (which == 0) {
            if (threadIdx.x == 0) { const unsigned tag = (unsigned)layer + 1u; if (st[8] != tag) { xcd_split_wait_t0((unsigned*)(ws + WS_CTL) + CW_SPLIT + layer * 2048, st[1], (unsigned*)(ws + WS_CTL) + CW_BAR); st[8] = tag; } }
            __builtin_amdgcn_s_barrier();
        }
        const int ia = which == 0 ? 0 : 2, ib = which == 0 ? 2 : 1;
        int rl0 = wr * 64 + fr, cl0 = wc * 32 + 8 * fq;
        asm volatile("" : "+v"(rl0), "+v"(cl0));
        const bf16_t* gta = Gp() + proj_gate_off(8 * ia + u.pn, u.pm, 0, 0); const bf16_t* gtb = Gp() + proj_gate_off(8 * ib + u.pn, u.pm, 0, 0);
        const unsigned lo0 = (unsigned)(rl0 * BM + cl0) * 2u;
#pragma unroll
        for (int ai = 0; ai < 2; ++ai) {
            v4u ga[4][2], gb[4][2];
#pragma unroll
            for (int m = 0; m < 4; ++m)
#pragma unroll
                for (int bj = 0; bj < 2; ++bj) {
                    const char* ba_ = (const char*)gta + ((ai * HALF + m * 16) * BM + bj * HALF) * 2; const char* bb_ = (const char*)gtb + ((ai * HALF + m * 16) * BM + bj * HALF) * 2;
                    if (which == 0) asm volatile("global_load_dwordx4 %0, %1, %2 nt" : "=v"(ga[m][bj]) : "v"(lo0), "s"(ba_) : "memory");
                    else asm volatile("global_load_dwordx4 %0, %1, %2" : "=v"(ga[m][bj]) : "v"(lo0), "s"(ba_) : "memory");
                    asm volatile("global_load_dwordx4 %0, %1, %2" : "=v"(gb[m][bj]) : "v"(lo0), "s"(bb_) : "memory"); }
            asm volatile("s_waitcnt vmcnt(0)" : "+v"(ga[0][0]), "+v"(ga[0][1]), "+v"(ga[1][0]), "+v"(ga[1][1]), "+v"(ga[2][0]), "+v"(ga[2][1]), "+v"(ga[3][0]), "+v"(ga[3][1]),
                                                 "+v"(gb[0][0]), "+v"(gb[0][1]), "+v"(gb[1][0]), "+v"(gb[1][1]), "+v"(gb[2][0]), "+v"(gb[2][1]), "+v"(gb[3][0]), "+v"(gb[3][1]) :: "memory");
#pragma unroll
            for (int m = 0; m < 4; ++m)
#pragma unroll
                for (int bj = 0; bj < 2; ++bj) { const v4u a = ga[m][bj], b = gb[m][bj]; f32x4 r0, r1;
#define GR_(ta, tb) ((1.0f + (tb)) * __builtin_amdgcn_rcpf(1.0f + (ta)))
                    r0[0] = GR_(h_lo(a.x), h_lo(b.x)); r0[1] = GR_(h_hi(a.x), h_hi(b.x)); r0[2] = GR_(h_lo(a.y), h_lo(b.y)); r0[3] = GR_(h_hi(a.y), h_hi(b.y));
                    r1[0] = GR_(h_lo(a.z), h_lo(b.z)); r1[1] = GR_(h_hi(a.z), h_hi(b.z)); r1[2] = GR_(h_lo(a.w), h_lo(b.w)); r1[3] = GR_(h_hi(a.w), h_hi(b.w));
#undef GR_
                    acc[ai][bj][m][0] *= r0; acc[ai][bj][m][1] *= r1; }
            asm volatile("" ::: "memory");
        }
    }
    __device__ __forceinline__ void operator()(const f32x4 (&acc)[2][2][4][2], const Unit& u, int wr, int wc, int fr, int fq) const {
        int row0 = u.pm * BM + wr * 64 + fr, col0 = u.pn * BM + wc * 32 + 8 * fq;
        asm volatile("" : "+v"(row0), "+v"(col0));
        v4u gw[2][4][2];
#pragma unroll
        for (int ai = 0; ai < 2; ++ai)
#pragma unroll
            for (int m = 0; m < 4; ++m)
#pragma unroll
                for (int bj = 0; bj < 2; ++bj) gw[ai][m][bj] = *(const v4u*)(Gp() + proj_gate_off(8 + u.pn, u.pm, (row0 & 255) + ai * HALF + m * 16, (col0 & 255) + bj * HALF));
#pragma unroll
        for (int ai = 0; ai < 2; ++ai)
#pragma unroll
            for (int m = 0; m < 4; ++m) { const int r = row0 + ai * HALF + m * 16;
#pragma unroll
                for (int bj = 0; bj < 2; ++bj) { const int c = col0 + bj * HALF; const v4u g = gw[ai][m][bj];
                    const f32x4 a0 = acc[ai][bj][m][0], a1 = acc[ai][bj][m][1]; v4u w;
#define SG_(t) __builtin_amdgcn_rcpf(1.0f + (t))
                    w.x = cvt_pk_bf16(a0[0] * SG_(h_lo(g.x)), a0[1] * SG_(h_hi(g.x))); w.y = cvt_pk_bf16(a0[2] * SG_(h_lo(g.y)), a0[3] * SG_(h_hi(g.y)));
                    w.z = cvt_pk_bf16(a1[0] * SG_(h_lo(g.z)), a1[1] * SG_(h_hi(g.z))); w.w = cvt_pk_bf16(a1[2] * SG_(h_lo(g.w)), a1[3] * SG_(h_hi(g.w)));
#undef SG_
                    *(v4u*)(mrgp() + (size_t)r * DM + c) = w; } }
    }
};
}
namespace att {
typedef short s16x4 __attribute__((ext_vector_type(4)));
typedef float f32x16 __attribute__((ext_vector_type(16)));
constexpr int KVBLK = 64, QBLK = 32, QB = 256;
constexpr int SHM_V = KVBLK * HD * 2, SHM_K = KVBLK * HD * 2;
constexpr int Q_OFF = 2 * SHM_V + 2 * SHM_K;
constexpr int WS_OFF = Q_OFF + 8 * 8192;
constexpr int BIAS_OFF = WS_OFF + NWAVES * 64 * 4;
constexpr int ATT_LDS = BIAS_OFF + 2048;
constexpr float C2 = 1.4426950408889634f * ATT_SCALE;
constexpr float THR = 8.f;
#define KSWZ(row, colB) ((row) * 256 + ((colB) ^ (((row) & 7) << 4)))
#define SBAR() __builtin_amdgcn_sched_barrier(0)
__device__ __forceinline__ int v_st(int k, int c) { const int kk = (k & ~0xC) | ((k & 4) << 1) | ((k & 8) >> 1); return ((kk >> 3) * 4 + (c >> 5)) * 512 + ((kk & 7) * 32 + (c & 31)) * 2; }
__device__ __forceinline__ int v_rd_base(int lane) { return ((lane & 3) << 3) | (((lane >> 2) & 3) << 6) | (((lane >> 4) & 1) << 5) | (((lane >> 5) & 1) << 8); }
constexpr int v_rd_off(int d0, int ks, int half) { return d0 * 512 + ks * 4096 + half * 2048; }
__device__ __forceinline__ int crow(int r, int hi) { return (r & 3) + 8 * (r >> 2) + 4 * hi; }
__device__ __forceinline__ void partialSM(f32x16& p0, f32x16& p1, float& m_reg, float& mn, float& alpha) {
    float pmax = p0[0];
#pragma unroll
    for (int r = 1; r < 16; ++r) pmax = fmaxf(pmax, p0[r]);
#pragma unroll
    for (int r = 0; r < 16; ++r) pmax = fmaxf(pmax, p1[r]);
    { auto rr = __builtin_amdgcn_permlane32_swap(__float_as_uint(pmax), __float_as_uint(pmax), false, false);
      pmax = fmaxf(__uint_as_float(rr[0]), __uint_as_float(rr[1])); }
    if (__builtin_expect(__all((pmax - m_reg) * ATT_SCALE <= THR), 1)) { mn = m_reg; alpha = 1.f; }
    else { mn = fmaxf(m_reg, pmax); alpha = __builtin_amdgcn_exp2f((m_reg - mn) * C2); m_reg = mn; }
    const float mnL = -mn * C2;
#pragma unroll
    for (int r = 0; r < 16; ++r) p0[r] = __builtin_amdgcn_exp2f(fmaf(p0[r], C2, mnL));
#pragma unroll
    for (int r = 0; r < 16; ++r) p1[r] = fmaf(p1[r], C2, mnL);
}
__device__ __forceinline__ void finishSM(f32x16& p0, f32x16& p1, float alpha, float& l_reg, bf16x8& pa0, bf16x8& pa1, bf16x8& pa2, bf16x8& pa3) {
#pragma unroll
    for (int r = 0; r < 16; ++r) p1[r] = __builtin_amdgcn_exp2f(p1[r]);
    float ps = 0;
#pragma unroll
    for (int r = 0; r < 16; ++r) ps += p0[r];
#pragma unroll
    for (int r = 0; r < 16; ++r) ps += p1[r];
    { auto rr = __builtin_amdgcn_permlane32_swap(__float_as_uint(ps), __float_as_uint(ps), false, false);
      ps = __uint_as_float(rr[0]) + __uint_as_float(rr[1]); }
    l_reg = l_reg * alpha + ps;
#define PK4(P, B_, OUT) do { unsigned a0 = cvt_pk_bf16(P[B_+0], P[B_+1]), a1 = cvt_pk_bf16(P[B_+2], P[B_+3]);                          \
        unsigned b0 = cvt_pk_bf16(P[B_+4], P[B_+5]), b1 = cvt_pk_bf16(P[B_+6], P[B_+7]);                                             \
        auto r0 = __builtin_amdgcn_permlane32_swap(a0, b0, false, false); auto r1 = __builtin_amdgcn_permlane32_swap(a1, b1, false, false); \
        v4u w = {r0[0], r1[0], r0[1], r1[1]}; OUT = __builtin_bit_cast(bf16x8, w); } while (0)
    PK4(p0, 0, pa0); PK4(p0, 8, pa1); PK4(p1, 0, pa2); PK4(p1, 8, pa3);
#undef PK4
}
template <int KB>
__device__ __forceinline__ void qkt(f32x16& p0, f32x16& p1, const char* K_lds, int r32, int hi, const char* ql, bool act) {
    if (!act) { const float NEG = -__builtin_inff();
#pragma unroll
        for (int r = 0; r < 16; ++r) { p0[r] = NEG; p1[r] = NEG; } return; }
    p0 = f32x16{}; p1 = f32x16{};
    const char* kb[4];
#pragma unroll
    for (int dd = 0; dd < 4; ++dd) kb[dd] = K_lds + KB * SHM_K + KSWZ(r32, (dd * 16 + hi * 8) * 2);
#pragma unroll
    for (int d0 = 0; d0 < 8; ++d0) { const char* a = kb[d0 & 3] + (d0 >> 2) * 128;
        bf16x8 b0 = *reinterpret_cast<const bf16x8*>(a);
        bf16x8 b1 = *reinterpret_cast<const bf16x8*>(a + 32 * 256);
        const bf16x8 qv = *reinterpret_cast<const bf16x8*>(ql + d0 * 8192);
        p0 = __builtin_amdgcn_mfma_f32_32x32x16_bf16(b0, qv, p0, 0, 0, 0);
        p1 = __builtin_amdgcn_mfma_f32_32x32x16_bf16(b1, qv, p1, 0, 0, 0); }
}
template <int VB>
__device__ __forceinline__ void pv_tile(f32x16* o, int vb0, bf16x8 pa0, bf16x8 pa1, bf16x8 pa2, bf16x8 pa3, bool act) {
    if (!act) return;
#define TRRD(dst, off) asm volatile("ds_read_b64_tr_b16 %0, %1 offset:%2" : "=&v"(dst) : "v"(vb0), "i"(off) : "memory")
#define PV_D0(d0) do { s16x4 l0, l1, l2, l3, h0, h1, h2, h3; constexpr int b_ = VB * SHM_V + v_rd_off(d0, 0, 0);     \
        TRRD(l0, b_); TRRD(h0, b_ + 2048); TRRD(l1, b_ + 4096); TRRD(h1, b_ + 6144); TRRD(l2, b_ + 8192); TRRD(h2, b_ + 10240); TRRD(l3, b_ + 12288); TRRD(h3, b_ + 14336); \
        asm volatile("s_waitcnt lgkmcnt(0)" ::: "memory"); SBAR();                                                     \
        o[d0] = __builtin_amdgcn_mfma_f32_32x32x16_bf16(pa0, (bf16x8){l0[0], l0[1], l0[2], l0[3], h0[0], h0[1], h0[2], h0[3]}, o[d0], 0, 0, 0);   \
        o[d0] = __builtin_amdgcn_mfma_f32_32x32x16_bf16(pa1, (bf16x8){l1[0], l1[1], l1[2], l1[3], h1[0], h1[1], h1[2], h1[3]}, o[d0], 0, 0, 0);   \
        o[d0] = __builtin_amdgcn_mfma_f32_32x32x16_bf16(pa2, (bf16x8){l2[0], l2[1], l2[2], l2[3], h2[0], h2[1], h2[2], h2[3]}, o[d0], 0, 0, 0);   \
        o[d0] = __builtin_amdgcn_mfma_f32_32x32x16_bf16(pa3, (bf16x8){l3[0], l3[1], l3[2], l3[3], h3[0], h3[1], h3[2], h3[3]}, o[d0], 0, 0, 0); } while (0)
    PV_D0(0); PV_D0(1); PV_D0(2); PV_D0(3);
#undef PV_D0
#undef TRRD
}

struct Item {
    const bf16* Q; const bf16* K; const bf16* V; bf16* O; float* LSE;
    int qs, os, lse_s;
    int P0, nseq, R, kind, pack; float m0, m0b, l0;
};
struct Bases { unsigned char* ws; const float* sink; };
__device__ __forceinline__ void attn_make_item(Item& it, int w, int k, const Bases& B) {
    const bf16* proj = (const bf16*)(B.ws + WS_PROJ); bf16* ocat = (bf16*)(B.ws + WS_OCAT); bf16* ob = (bf16*)(B.ws + WS_OB); float* lb = (float*)(B.ws + WS_LB); const float* sink = B.sink;
    it.LSE = nullptr; it.lse_s = 0; it.m0 = -1e30f; it.l0 = 0.f; it.qs = HD; it.os = KBR; it.nseq = SEQ; it.R = 128; it.kind = 0; it.pack = 0; it.m0b = 0.f;
    if (k < 2) {
        const int a = w + 256 * k, b = a >> 7, kvh = (a >> 6) & 1, pr = (a >> 5) & 1, blk = a & 31, h = 4 * kvh + 2 * pr; const bf16* pb = proj + (size_t)b * SEQ * HD;
        it.Q = pb + (size_t)(OFF_QA / HD + h) * M * HD; it.K = pb + (size_t)(OFF_KA / HD + kvh) * M * HD; it.V = pb + (size_t)(OFF_VA / HD + kvh) * M * HD; it.O = ocat + (size_t)b * SEQ * KBR + OC_A + 128 * h;
        it.P0 = blk * 128; it.pack = 1; it.m0 = sink[h] * (1.0f / ATT_SCALE); it.m0b = sink[h + 1] * (1.0f / ATT_SCALE); it.l0 = 1.f;
    } else if (k < 4) {
        const int c = w + 256 * (k - 2), b = c >> 7, h = (c >> 4) & 7, blk = c & 15; const bf16* pb = proj + (size_t)b * SEQ * HD;
        it.Q = pb + (size_t)(OFF_QC / HD + h) * M * HD; it.K = pb + (size_t)(OFF_KC / HD + h) * M * HD; it.V = pb + (size_t)(OFF_VC / HD + h) * M * HD; it.O = ocat + (size_t)b * SEQ * KBR + OC_C + 128 * h;
        it.P0 = blk * 256; it.kind = 1;
    } else {
        const int g = k - 4, i = w, b = i >> 6, hg = (i >> 4) & 3; int r, blk, dil;
        if (g == 0) { dil = 1; r = 0; blk = i & 15; } else if (g == 1) { dil = 4; r = (i >> 2) & 3; blk = i & 3; } else { dil = 16; r = i & 15; blk = 0; }
        const int head = 4 * g + hg; const size_t row0 = (size_t)b * SEQ + r; const bf16* pb = proj + row0 * HD;
        it.Q = pb + (size_t)(OFF_QB / HD + head) * M * HD; it.K = pb + (size_t)(OFF_KB / HD + head) * M * HD; it.V = pb + (size_t)(OFF_VB / HD + head) * M * HD;
        it.O = ob + ((size_t)g * M + row0) * 512 + 128 * hg; it.LSE = lb + ((size_t)g * M + row0) * 4 + hg;
        it.qs = dil * HD; it.os = dil * 512; it.lse_s = dil * 4; it.nseq = SEQ / dil; it.R = 64; it.P0 = blk * 256;
    }
}
struct Pre { bf16x8 v0, v1; };
__device__ __forceinline__ int item_jlo(const Item& it) {
    if (it.kind == 0) return (it.P0 - it.R) < 0 ? 0 : (it.P0 - it.R) / KVBLK;
    const int r0 = it.P0 >> 6; int a_ = r0 - 4; a_ = a_ < 0 ? 0 : (a_ > 56 ? 56 : a_); return a_;
}
__device__ __forceinline__ void item_prefetch_k(const Item& it, char* lds) {
    int tid = threadIdx.x; asm volatile("" : "+v"(tid));
    const int wid = __builtin_amdgcn_readfirstlane(tid >> 6);
    const int sr = tid >> 4, sck = ((tid & 15) ^ (sr & 7)) * 8;
    const unsigned rb_ = (unsigned)((item_jlo(it) * KVBLK + sr) * it.qs), r1_ = (unsigned)(32 * it.qs);
    __builtin_amdgcn_global_load_lds((const GAS unsigned*)(it.K + rb_ + sck), (LAS unsigned*)(lds + 2 * SHM_V + wid * 1024), 16, 0, 0);
    __builtin_amdgcn_global_load_lds((const GAS unsigned*)(it.K + rb_ + r1_ + sck), (LAS unsigned*)(lds + 2 * SHM_V + 32 * 256 + wid * 1024), 16, 0, 0);
}
__device__ __forceinline__ void item_prefetch_v(const Item& it, Pre& p) {
    int tid = threadIdx.x; asm volatile("" : "+v"(tid));
    const int sr = tid >> 4, sc = (tid & 15) * 8;
    const unsigned rb_ = (unsigned)((item_jlo(it) * KVBLK + sr) * it.qs), r1_ = (unsigned)(32 * it.qs);
    p.v0 = *(const bf16x8*)(it.V + rb_ + sc); p.v1 = *(const bf16x8*)(it.V + rb_ + r1_ + sc);
}
__device__ __forceinline__ void item_prefetch_q(const Item& it, char* lds) {
    int tid = threadIdx.x; asm volatile("" : "+v"(tid));
    const int wid = __builtin_amdgcn_readfirstlane(tid >> 6), lane = tid & 63, r32 = lane & 31, hi = lane >> 5;
    const int hsel = it.pack ? (wid >> 2) : 0, wrow = it.pack ? (wid & 3) : wid;
    const int qpos = it.P0 + wrow * QBLK + r32;
    const bf16* qp = it.Q + (unsigned)(qpos * it.qs + hi * 8 + hsel * (M * HD));
#pragma unroll
    for (int d0 = 0; d0 < 8; ++d0)
        __builtin_amdgcn_global_load_lds((const GAS unsigned*)(qp + d0 * 16), (LAS unsigned*)(lds + Q_OFF + d0 * 8192 + wid * 1024), 16, 0, 0);
}
template <int G> __device__ __forceinline__ void bias8(unsigned bpa, float (&b0)[4], float (&b1)[4]) {
#define BRD_(dst, off) asm volatile("ds_read_b32 %0, %1 offset:%2" : "=v"(dst) : "v"(bpa), "i"(off) : "memory")
    BRD_(b0[0], (8 * G + 0) * 4); BRD_(b0[1], (8 * G + 1) * 4); BRD_(b0[2], (8 * G + 2) * 4); BRD_(b0[3], (8 * G + 3) * 4);
    BRD_(b1[0], (8 * G + 32) * 4); BRD_(b1[1], (8 * G + 33) * 4); BRD_(b1[2], (8 * G + 34) * 4); BRD_(b1[3], (8 * G + 35) * 4);
#undef BRD_
    asm volatile("s_waitcnt lgkmcnt(0)" : "+v"(b0[0]), "+v"(b0[1]), "+v"(b0[2]), "+v"(b0[3]), "+v"(b1[0]), "+v"(b1[1]), "+v"(b1[2]), "+v"(b1[3]) :: "memory");
}
__device__ __forceinline__ void attn_item(const Item& it, char* lds, Pre& pre, bool has_next, int w, int kn, const Bases& B) {
    const int KIND = it.kind;
    int tid = threadIdx.x; asm volatile("" : "+v"(tid));
    const int wid = __builtin_amdgcn_readfirstlane(tid >> 6), lane = tid & 63, r32 = lane & 31, hi = lane >> 5;
    char* V_lds = lds; char* K_lds = lds + 2 * SHM_V;
    float* ws = (float*)(lds + WS_OFF) + wid * 64; float* li_l = ws; float* al_l = ws + 32;
    const float* bias_l = (const float*)(lds + BIAS_OFF);
    const int hsel = it.pack ? (wid >> 2) : 0, wrow = it.pack ? (wid & 3) : wid, nrows = it.pack ? 128 : QB;
    const int qlo = it.P0 + wrow * QBLK, qpos = qlo + r32;
    int j_lo, j_hi;
    if (KIND == 0) { j_lo = (it.P0 - it.R) < 0 ? 0 : (it.P0 - it.R) / KVBLK; j_hi = (it.P0 + nrows - 1 + it.R) / KVBLK + 1; if (j_hi > it.nseq / KVBLK) j_hi = it.nseq / KVBLK; }
    else { const int r0 = it.P0 >> 6; int a = r0 - 4; a = a < 0 ? 0 : (a > 56 ? 56 : a); int b = r0 + 3 - 4; b = b < 0 ? 0 : (b > 56 ? 56 : b); j_lo = a; j_hi = b + 8; }
    const int NT = j_hi - j_lo;
    int wa, wb;
    if (KIND == 0) { wa = (qlo - it.R) < 0 ? 0 : (qlo - it.R) / KVBLK; wb = (qlo + QBLK - 1 + it.R) / KVBLK + 1; }
    else { const int qr = qlo >> 6; int a = qr - 4; a = a < 0 ? 0 : (a > 56 ? 56 : a); wa = a; wb = a + 8; }
    char* ql = lds + Q_OFF + tid * 16;

    const int sr = tid >> 4, sc = (tid & 15) * 8, vst0 = v_st(sr, sc), vst1 = v_st(32 + sr, sc), kws = KSWZ(sr, sc * 2);
    const int vb0 = (int)(uintptr_t)V_lds + v_rd_base(lane);
    bf16x8 st_k0, st_k1, st_v0, st_v1;
#define SLOAD(t) do { const unsigned r0_ = (unsigned)(((j_lo + (t)) * KVBLK + sr) * it.qs + sc), r1_ = r0_ + (unsigned)(32 * it.qs);   \
        st_v0 = *(const bf16x8*)(it.V + r0_); st_v1 = *(const bf16x8*)(it.V + r1_); st_k0 = *(const bf16x8*)(it.K + r0_); st_k1 = *(const bf16x8*)(it.K + r1_); } while (0)
#define SWRITE(bf) do { *(bf16x8*)(V_lds + (bf) * SHM_V + vst0) = st_v0; *(bf16x8*)(V_lds + (bf) * SHM_V + vst1) = st_v1;   \
        *(bf16x8*)(K_lds + (bf) * SHM_K + kws) = st_k0; *(bf16x8*)(K_lds + (bf) * SHM_K + kws + 32 * 256) = st_k1; } while (0)
#define ACT(t) ((j_lo + (t)) >= wa && (j_lo + (t)) < wb)
#define MASKC_G(P0_, P1_, g) do { float b0_[4], b1_[4]; bias8<g>(bpa, b0_, b1_);                                                              \
        _Pragma("unroll") for (int i_ = 0; i_ < 4; ++i_) { const int r = 4 * (g) + i_, c = i_ + 8 * (g);                                        \
            P0_[r] = ((unsigned)(kc0 + c) < 16u) ? P0_[r] + b0_[i_] : NEG; P1_[r] = ((unsigned)(kc0 + c + 32) < 16u) ? P1_[r] + b1_[i_] : NEG; } \
        SBAR(); } while (0)
#define MASKT(P0_, P1_, t) do { if (ACT(t)) { const int jt_ = j_lo + (t); const float NEG = -__builtin_inff();                            \
        if (KIND == 0) { const int dq = qpos - jt_ * KVBLK - 4 * hi + it.R; const unsigned w2 = 2u * (unsigned)it.R;                        \
            _Pragma("unroll") for (int r = 0; r < 16; ++r) { const int c = (r & 3) + 8 * (r >> 2);                                          \
                if ((unsigned)(dq - c) > w2) P0_[r] = NEG; if ((unsigned)(dq - c - 32) > w2) P1_[r] = NEG; } }                              \
        else { const int qc = qpos & 63, qrow = qpos >> 6; int cs = qc - 8; cs = cs < 0 ? 0 : (cs > 48 ? 48 : cs);                          \
            const unsigned bpa = (unsigned)(uintptr_t)(bias_l + ((jt_ - qrow + 7) * 31 + 15 - qc + 4 * hi)); const int kc0 = 4 * hi - cs;      \
            MASKC_G(P0_, P1_, 0); MASKC_G(P0_, P1_, 1); MASKC_G(P0_, P1_, 2); MASKC_G(P0_, P1_, 3); } } } while (0)
#define RESC(a) do { if (__any((a) < 1.f)) { if (hi == 0) al_l[r32] = (a); asm volatile("s_waitcnt lgkmcnt(0)" ::: "memory");              \
        _Pragma("unroll") for (int d_ = 0; d_ < 4; ++d_) _Pragma("unroll") for (int r = 0; r < 16; ++r) o[d_][r] *= al_l[crow(r, hi)]; } } while (0)
    float m_reg = hsel ? it.m0b : it.m0, l_reg = it.l0; f32x16 o[4] = {};
    f32x16 pA0, pA1, pB0, pB1; float mnA, mnB, alA, alB; bf16x8 pa0, pa1, pa2, pa3;
    *(bf16x8*)(V_lds + vst0) = pre.v0; *(bf16x8*)(V_lds + vst1) = pre.v1;
    if (NT > 1) { SLOAD(1); asm volatile("s_waitcnt vmcnt(4)" ::: "memory"); } else asm volatile("s_waitcnt vmcnt(0)" ::: "memory");
    __syncthreads();
    SBAR(); qkt<0>(pA0, pA1, K_lds, r32, hi, ql, ACT(0));
    MASKT(pA0, pA1, 0); partialSM(pA0, pA1, m_reg, mnA, alA);
    if (NT > 1) SWRITE(1);
    __syncthreads();
#define HALF_STEP(PX0, PX1, mnX, alX, PY0, PY1, alY, t, KB, VB, SB) do {                                                      \
        SBAR(); qkt<KB>(PX0, PX1, K_lds, r32, hi, ql, ACT(t));                                                               \
        finishSM(PY0, PY1, alY, l_reg, pa0, pa1, pa2, pa3); SBAR();                                                           \
        if ((t) + 1 < NT) { SLOAD((t) + 1); SBAR(); }                                                                         \
        pv_tile<VB>(o, vb0, pa0, pa1, pa2, pa3, ACT((t) - 1)); MASKT(PX0, PX1, (t)); partialSM(PX0, PX1, m_reg, mnX, alX);     \
        __syncthreads();                                                                                                      \
        if ((t) + 1 < NT) { SWRITE(SB); }                                                                                     \
        RESC(alX); __syncthreads(); } while (0)
    for (int t = 1; t + 1 < NT; t += 2) {
        HALF_STEP(pB0, pB1, mnB, alB, pA0, pA1, alA, t, 1, 0, 0);
        HALF_STEP(pA0, pA1, mnA, alA, pB0, pB1, alB, t + 1, 0, 1, 1);
    }
    const bool even = (NT & 1) == 0;
    if (even) { SBAR(); qkt<1>(pB0, pB1, K_lds, r32, hi, ql, ACT(NT - 1)); SBAR(); }
    finishSM(pA0, pA1, alA, l_reg, pa0, pa1, pa2, pa3); SBAR();
    pv_tile<0>(o, vb0, pa0, pa1, pa2, pa3, ACT(even ? NT - 2 : NT - 1));
    if (even) { MASKT(pB0, pB1, NT - 1); partialSM(pB0, pB1, m_reg, mnB, alB); RESC(alB);
        finishSM(pB0, pB1, alB, l_reg, pa0, pa1, pa2, pa3); SBAR(); pv_tile<1>(o, vb0, pa0, pa1, pa2, pa3, ACT(NT - 1)); }
#undef HALF_STEP
#undef RESC
#undef MASKT
#undef MASKC_G
#undef ACT
#undef SLOAD
#undef SWRITE
    if (has_next) { Item nx; attn_make_item(nx, w, kn, B); item_prefetch_k(nx, lds); }
    if (hi == 0) li_l[r32] = l_reg; asm volatile("s_waitcnt lgkmcnt(0)" ::: "memory");
    { char* ob_ = lds + Q_OFF + wid * 1024;
      const bool odd = (r32 & 1) != 0; char* wp = ob_ + hi * 8192 + (odd ? (r32 - 1) * 2 + 256 : r32 * 2);
      f32x4 rl4[4];
#pragma unroll
      for (int g = 0; g < 4; ++g) rl4[g] = *(const f32x4*)(li_l + 8 * g + 4 * hi);
#pragma unroll
      for (int r = 0; r < 16; r += 2) { const float ra = __builtin_amdgcn_rcpf(rl4[r >> 2][r & 3]), rb = __builtin_amdgcn_rcpf(rl4[r >> 2][(r & 3) + 1]);
#pragma unroll
          for (int d0 = 0; d0 < 4; ++d0) { const float va = o[d0][r] * ra, vb = o[d0][r + 1] * rb;
              const float y = lane_xor1(odd ? va : vb);
              *(unsigned*)(wp + (2 * (r >> 2)) * 8192 + (r & 3) * 256 + d0 * 64) = cvt_pk_bf16(odd ? y : va, odd ? vb : y); } }
      asm volatile("s_waitcnt lgkmcnt(0)" ::: "memory");
      bf16* Og = it.O + (unsigned)((qlo + (lane >> 4)) * it.os + hsel * HD + (lane & 15) * 8);
#pragma unroll
      for (int j = 0; j < 8; ++j) { const v4u w = *(const v4u*)(ob_ + j * 8192 + lane * 16); *(v4u*)(Og + (unsigned)(4 * j * it.os)) = w; } }
    if (has_next) { asm volatile("s_waitcnt lgkmcnt(0)" ::: "memory"); Item nx; attn_make_item(nx, w, kn, B); item_prefetch_q(nx, lds); item_prefetch_v(nx, pre); }
    else { pre.v0 = (bf16x8){0, 0, 0, 0, 0, 0, 0, 0}; pre.v1 = pre.v0; }
    if (it.LSE != nullptr && hi == 0) it.LSE[(unsigned)(qpos * it.lse_s)] = m_reg * ATT_SCALE + __logf(l_reg);
    __syncthreads();
}
#undef KSWZ
#undef SBAR
}
template <int MAP> __device__ __forceinline__ void cvt_unit(const float* __restrict__ W, int N, bf16* __restrict__ Bt, int ldb, int koff, const float* __restrict__ gain, int n0, int k0, int lane) {
    const int kg = lane >> 3, ng = lane & 7, nn0 = n0 + 4 * ng, r0 = map_row<MAP>(nn0);
#pragma unroll 1
    for (int pass = 0; pass < 4; pass += 2) {
        f32x4 v[2][8];
#pragma unroll
        for (int p = 0; p < 2; ++p)
#pragma unroll
            for (int i = 0; i < 8; ++i) v[p][i] = __builtin_nontemporal_load((const f32x4*)(W + (size_t)(k0 + (pass + p) * 64 + 8 * kg + i) * N + nn0));
#pragma unroll
        for (int p = 0; p < 2; ++p) { const int kb = k0 + (pass + p) * 64 + 8 * kg;
            f32x4 g0 = {1.f, 1.f, 1.f, 1.f}, g1 = {1.f, 1.f, 1.f, 1.f};
            if (gain) { g0 = *(const f32x4*)(gain + kb); g1 = *(const f32x4*)(gain + kb + 4); }
#pragma unroll
            for (int nn = 0; nn < 4; ++nn) { v4u o;
                o.x = cvt_pk_bf16(v[p][0][nn] * g0[0], v[p][1][nn] * g0[1]); o.y = cvt_pk_bf16(v[p][2][nn] * g0[2], v[p][3][nn] * g0[3]);
                o.z = cvt_pk_bf16(v[p][4][nn] * g1[0], v[p][5][nn] * g1[1]); o.w = cvt_pk_bf16(v[p][6][nn] * g1[2], v[p][7][nn] * g1[3]);
                *(v4u*)(Bt + (size_t)(r0 + nn) * ldb + koff + kb) = o; } }
    }
}

struct Args { const float* in[13]; float* out; unsigned char* ws; int ph_lo, ph_hi; };
#define CAS __attribute__((address_space(4)))
#define GIN(k) ((const float*)(const GAS float*)ap->in[k])
#define GOUT ((float*)(GAS float*)ap->out)
struct Frame {
    LAS unsigned char* lds;
    int tid, lane, wave, G, gw, ngw, bx;
    unsigned char* ws;
};

constexpr int CU_IN = (NIN / 32) * (DM / 256), CU_BA = (DM / 32) * (1024 / 256), CU_BB = (DM / 32) * (512 / 256), CU_BC = CU_BA, CU_O = (DM / 32) * (DM / 256),
              CU_GU = (NGU / 32) * (DM / 256), CU_D = (DM / 32) * (DFF / 256), CU_LAYER = CU_IN + CU_BA + CU_BB + CU_BC + CU_O + CU_GU + CU_D;
static_assert(CU_LAYER == 9216, "conversion units per layer");

__device__ __forceinline__ void p0_prologue(const Frame& F, const CAS Args* ap) {
    { unsigned* rope = (unsigned*)(F.ws + WS_ROPE);
      for (int e = blockIdx.x * (NWAVES * 64) + F.tid; e < SEQ * 64; e += F.G * NWAVES * 64) { const int pos = e >> 6, i = e & 63;
          double fr_ = 1.0; { const double q1 = 0.86596432336006535, q2 = q1 * q1, q4 = q2 * q2, q8 = q4 * q4, q16 = q8 * q8, q32 = q16 * q16;
            if (i & 1) fr_ *= q1; if (i & 2) fr_ *= q2; if (i & 4) fr_ *= q4; if (i & 8) fr_ *= q8; if (i & 16) fr_ *= q16; if (i & 32) fr_ *= q32; }
          double r = (double)pos * (double)(float)fr_ * 0.15915494309189533577; r -= __builtin_floor(r);
          const float rf = (float)r; rope[e] = cvt_pk_f16(__builtin_amdgcn_cosf(rf), __builtin_amdgcn_sinf(rf)); } }
    for (int u = F.gw; u < DEPTH * CU_LAYER; u += F.ngw) {
        const int layer = u / CU_LAYER; int r = u - layer * CU_LAYER;
        bf16* wl = (bf16*)(F.ws + WS_W + (size_t)layer * LW_SZ);
        if (r < CU_IN) { cvt_unit<MAP_IN>(GIN(2) + (size_t)layer * DM * NIN, NIN, (bf16*)((char*)wl + LW_IN), DM, 0, GIN(1) + layer * DM, 32 * (r % (NIN / 32)), 256 * (r / (NIN / 32)), F.lane); continue; } r -= CU_IN;
        if (r < CU_BA) { cvt_unit<MAP_V>(GIN(6) + (size_t)layer * 1024 * DM, DM, (bf16*)((char*)wl + LW_BR), KBR, 0, nullptr, 32 * (r % (DM / 32)), 256 * (r / (DM / 32)), F.lane); continue; } r -= CU_BA;
        if (r < CU_BB) { cvt_unit<MAP_V>(GIN(7) + (size_t)layer * 512 * DM, DM, (bf16*)((char*)wl + LW_BR), KBR, 1024, nullptr, 32 * (r % (DM / 32)), 256 * (r / (DM / 32)), F.lane); continue; } r -= CU_BB;
        if (r < CU_BC) { cvt_unit<MAP_V>(GIN(8) + (size_t)layer * 1024 * DM, DM, (bf16*)((char*)wl + LW_BR), KBR, 1536, nullptr, 32 * (r % (DM / 32)), 256 * (r / (DM / 32)), F.lane); continue; } r -= CU_BC;
        if (r < CU_O) { cvt_unit<MAP_V>(GIN(9) + (size_t)layer * DM * DM, DM, (bf16*)((char*)wl + LW_O), DM, 0, nullptr, 32 * (r % (DM / 32)), 256 * (r / (DM / 32)), F.lane); continue; } r -= CU_O;
        if (r < CU_GU) { cvt_unit<MAP_GU>(GIN(11) + (size_t)layer * DM * NGU, NGU, (bf16*)((char*)wl + LW_GU), DM, 0, GIN(10) + layer * DM, 32 * (r % (NGU / 32)), 256 * (r / (NGU / 32)), F.lane); continue; } r -= CU_GU;
        cvt_unit<MAP_V>(GIN(12) + (size_t)layer * DFF * DM, DM, (bf16*)((char*)wl + LW_D), DFF, 0, nullptr, 32 * (r % (DM / 32)), 256 * (r / (DM / 32)), F.lane);
    }
}

__device__ __forceinline__ void x_to_bf16_ssq(const Frame& F, const float* x, bf16* xb, float* ssq) {
    for (int row = F.gw; row < M; row += F.ngw) {
        const f32x4* xr = (const f32x4*)(x + (size_t)row * DM) + F.lane;
        f32x4 v[8]; float s[8];
#pragma unroll
        for (int j = 0; j < 8; ++j) { v[j] = xr[64 * j]; s[j] = (v[j][0] * v[j][0] + v[j][1] * v[j][1]) + (v[j][2] * v[j][2] + v[j][3] * v[j][3]); }
        v2u* o = (v2u*)(xb + (size_t)row * DM) + F.lane;
#pragma unroll
        for (int j = 0; j < 8; ++j) { v2u w; w.x = cvt_pk_bf16(v[j][0], v[j][1]); w.y = cvt_pk_bf16(v[j][2], v[j][3]); o[64 * j] = w; s[j] = wave_sum(s[j]); }
        if (F.lane == 0) { *(f32x4*)(ssq + (size_t)row * 8) = (f32x4){s[0], s[1], s[2], s[3]}; *(f32x4*)(ssq + (size_t)row * 8 + 4) = (f32x4){s[4], s[5], s[6], s[7]}; }
    }
}
__device__ __forceinline__ void rs_issue(const Frame& F, const float* ssq, int pbase, f32x4 (&s)[4][2]) {
#pragma unroll
    for (int i = 0; i < 4; ++i) { const f32x4* sp = (const f32x4*)(ssq + ((size_t)pbase * 256 + F.tid + i * (NWAVES * 64)) * 8); s[i][0] = sp[0]; s[i][1] = sp[1]; }
}
__device__ __forceinline__ void rs_table_load(const Frame& F, const float* ssq, int pbase, LAS float* RS) {
    f32x4 s[4][2];
#pragma unroll
    for (int i = 0; i < 4; ++i) { const f32x4* sp = (const f32x4*)(ssq + ((size_t)pbase * 256 + F.tid + i * (NWAVES * 64)) * 8); s[i][0] = sp[0]; s[i][1] = sp[1]; }
#pragma unroll
    for (int i = 0; i < 4; ++i) { const f32x4 s0 = s[i][0], s1 = s[i][1];
        RS[F.tid + i * (NWAVES * 64)] = __builtin_amdgcn_rsqf((((s0[0] + s0[1]) + (s0[2] + s0[3])) + ((s1[0] + s1[1]) + (s1[2] + s1[3]))) * (1.0f / DM) + NORM_EPS); }
    asm volatile("s_waitcnt lgkmcnt(0)" ::: "memory"); __syncthreads();
}
__device__ __forceinline__ void attn_phase(const Frame& F, char* lds, unsigned char* ws, const float* sink  , const float* rpb  ) {
    const int G = F.G; const att::Bases B{ws, sink};
#pragma unroll 1
    for (int w = F.bx; w < 256; w += G) {
        att::Pre pre;
        { att::Item it0; att::attn_make_item(it0, w, 0, B); att::item_prefetch_k(it0, lds); att::item_prefetch_q(it0, lds); att::item_prefetch_v(it0, pre); }
        { const int h = (w >> 4) & 7; float* bl = (float*)(lds + att::BIAS_OFF); for (int i = F.tid; i < 15 * 31; i += NWAVES * 64) bl[i] = rpb[h * 465 + i] * (1.0f / ATT_SCALE); }
#pragma unroll 1
        for (int k = 0; k < 7; ++k) {
            att::Item cur; att::attn_make_item(cur, w, k, B);
            att::attn_item(cur, lds, pre, k + 1 < 7, w, k + 1, B);
        }
        __syncthreads();
    }
}
template <int NR>
__device__ __forceinline__ void bcombine_rows_n(const bf16* ob, const float* lb, bf16* ocat, int row0, int rstep, int lane) {
    const int hg = lane >> 4, c8 = (lane & 15) * 8;
    float l[NR][3]; v4u w[NR][3];
#pragma unroll
    for (int i = 0; i < NR; ++i)
#pragma unroll
        for (int g = 0; g < 3; ++g) { const int row = row0 + i * rstep; l[i][g] = lb[((size_t)g * M + row) * 4 + hg]; w[i][g] = *(const v4u*)(ob + ((size_t)g * M + row) * 512 + 128 * hg + c8); }
#pragma unroll
    for (int i = 0; i < NR; ++i) { const int row = row0 + i * rstep;
        const float mx = fmaxf(l[i][0], fmaxf(l[i][1], l[i][2])); float e[3], s = 0.f;
#pragma unroll
        for (int g = 0; g < 3; ++g) { e[g] = __expf(l[i][g] - mx); s += e[g]; }
        const float inv = __builtin_amdgcn_rcpf(s); float acc[8] = {0.f, 0.f, 0.f, 0.f, 0.f, 0.f, 0.f, 0.f};
#pragma unroll
        for (int g = 0; g < 3; ++g) { const float wg = e[g] * inv; const v4u u = w[i][g];
            acc[0] += wg * bf_lo(u.x); acc[1] += wg * bf_hi(u.x); acc[2] += wg * bf_lo(u.y); acc[3] += wg * bf_hi(u.y);
            acc[4] += wg * bf_lo(u.z); acc[5] += wg * bf_hi(u.z); acc[6] += wg * bf_lo(u.w); acc[7] += wg * bf_hi(u.w); }
        v4u o; o.x = cvt_pk_bf16(acc[0], acc[1]); o.y = cvt_pk_bf16(acc[2], acc[3]); o.z = cvt_pk_bf16(acc[4], acc[5]); o.w = cvt_pk_bf16(acc[6], acc[7]);
        *(v4u*)(ocat + (size_t)row * KBR + OC_B + 128 * hg + c8) = o; }
}
__device__ __forceinline__ void bcombine_rows(const Frame& F, const bf16* ob, const float* lb, bf16* ocat) {
    int row = F.gw;
    for (; row + 3 * F.ngw < M; row += 4 * F.ngw) bcombine_rows_n<4>(ob, lb, ocat, row, F.ngw, F.lane);
    for (; row < M; row += F.ngw) bcombine_rows_n<1>(ob, lb, ocat, row, F.ngw, F.lane);
}

#ifndef MK_SINGLE
#define MK_SINGLE 1
#endif
constexpr int NPH = 7;
constexpr int NPHASES = 1 + DEPTH * NPH;
__global__ void __launch_bounds__(NWAVES * 64, 2) mk_fwd(Args args) {
    extern __shared__ __attribute__((aligned(16))) unsigned char lds[];
    const int tid0 = threadIdx.x;
    volatile LAS unsigned* MISC = (volatile LAS unsigned*)((LAS unsigned char*)lds + MISC_OFF);
    if (tid0 < 32) MISC[tid0] = 0u;
    __syncthreads();
    const int lo = args.ph_lo, hi = args.ph_hi; const bool multi = (hi - lo) > 1;
    XcdBarrier bar; bar.bar = (unsigned*)(args.ws + WS_CTL) + CW_BAR; bar.x = 0; bar.st = MISC + 8;
    if (multi) bar = xcd_barrier_post((unsigned*)(args.ws + WS_CTL) + CW_BAR, MISC + 8);
#define IN(k) (lo <= (k) && (k) < hi)
#define SEAM(k) do { if (IN((k) + 1)) xcd_barrier(bar); } while (0)


#define XN ((bf16*)(wsb + WS_XN))
#define PROJ ((bf16*)(wsb + WS_PROJ))
#define HID ((bf16*)(wsb + WS_HID))
#define OCAT ((bf16*)(wsb + WS_OCAT))
#define MRG ((bf16*)(wsb + WS_MRG))
#define MACC ((float*)(wsb + WS_MACC))
#define SSQB ((float*)(wsb + WS_SSQ))
#define XLO ((bf16*)(wsb + WS_XLO))
#define OB ((bf16*)(wsb + WS_OB))
#define LB ((float*)(wsb + WS_LB))
#define WL(off) ((const bf16*)(wsb + WS_W + (size_t)layer * LW_SZ + (off)))
#define OPQ() const CAS Args* ap; { const CAS char* kp_ = (const CAS char*)__builtin_amdgcn_kernarg_segment_ptr(); asm volatile("" : "+s"(kp_)); ap = (const CAS Args*)kp_; } GAS unsigned char* wsg_ = (GAS unsigned char*)ap->ws; asm volatile("" : "+s"(wsg_)); unsigned char* wsb = (unsigned char*)wsg_; Frame F; { int t_ = threadIdx.x; asm volatile("" : "+v"(t_)); F.lds = (LAS unsigned char*)lds; F.tid = t_; F.lane = t_ & 63; \
    F.wave = __builtin_amdgcn_readfirstlane(t_ >> 6); F.G = gridDim.x; { int bx_ = blockIdx.x; asm volatile("" : "+s"(bx_)); F.bx = bx_; } F.gw = F.bx * NWAVES + F.wave; F.ngw = F.G * NWAVES; F.ws = wsb; }
    if (IN(0)) { OPQ(); p0_prologue(F, ap); x_to_bf16_ssq(F, GIN(0), XN, SSQB); SEAM(0); }
#pragma unroll 1
    for (int layer_ = 0; layer_ < DEPTH; ++layer_) {
        int layer = layer_; asm volatile("" : "+s"(layer));
        const int pb = 1 + layer * NPH;
        if (pb >= hi || pb + NPH <= lo) continue;
        if (IN(pb + 0)) { OPQ(); pg8::Gemm g{XN, WL(LW_IN), DM, DM, M, NIN, DM}; pg8::StaticOrder S; S.init(M, NIN, F.G, F.bx); pg8::Unit u0; S.next(0, u0);
            pg8::EpiProj E{PROJ, GIN(3) + layer * 6 * HD, (const unsigned*)(wsb + WS_ROPE), (LAS float*)(F.lds + XCH_OFF), (const LAS float*)(F.lds + RS_OFF)}; rs_issue(F, SSQB, u0.pm & ~7, E.rsv);
            pg8::gemm_phase<pg8::EpiProj, pg8::StaticOrder, true, true>(F.lds + RING_OFF, g, S, E); SEAM(pb + 0); }
        if (IN(pb + 1)) { OPQ(); attn_phase(F, (char*)lds, wsb, GIN(4) + layer * 8, GIN(5) + layer * 8 * 15 * 31); SEAM(pb + 1); }
        if (IN(pb + 2)) { OPQ(); bcombine_rows(F, OB, LB, OCAT); xcd_split_arrive(bar, (unsigned*)(wsb + WS_CTL) + CW_SPLIT + layer * 2048); }
        if (IN(pb + 3)) { OPQ(); pg8::Gemm g{OCAT, WL(LW_BR), KBR, KBR, M, DM, KBR}; pg8::StaticOrder S; S.init(M, DM, F.G, F.bx); pg8::EpiBranch E{wsb, layer, MISC + 8};
            pg8::gemm_phase<pg8::EpiBranch, pg8::StaticOrder, true, true>(F.lds + RING_OFF, g, S, E); SEAM(pb + 3); }
        if (IN(pb + 4)) { OPQ(); pg8::Gemm g{MRG, WL(LW_O), DM, DM, M, DM, DM}; pg8::StaticOrder S; S.init(M, DM, F.G, F.bx); pg8::EpiResNorm E{(float*)nullptr, XN, SSQB, (LAS float*)(F.lds + XCH_OFF)};
            pg8::gemm_phase<pg8::EpiResNorm, pg8::StaticOrder, true, true>(F.lds + RING_OFF, g, S, E); SEAM(pb + 4); }
        if (IN(pb + 5)) { OPQ(); pg8::Gemm g{XN, WL(LW_GU), DM, DM, M, NGU, DM}; pg8::StaticOrder S; S.init(M, NGU, F.G, F.bx); pg8::Unit u0; S.next(0, u0);
            pg8::EpiSwiglu E{HID, (const LAS float*)(F.lds + RS_OFF)}; rs_issue(F, SSQB, u0.pm & ~7, E.rsv);
            pg8::gemm_phase<pg8::EpiSwiglu, pg8::StaticOrder, true, true>(F.lds + RING_OFF, g, S, E); SEAM(pb + 5); }
        if (IN(pb + 6)) { OPQ(); pg8::Gemm g{HID, WL(LW_D), DFF, DFF, M, DM, DFF}; pg8::StaticOrder S; S.init(M, DM, F.G, F.bx); pg8::EpiResNorm E{layer == DEPTH - 1 ? GOUT : (float*)nullptr, XN, SSQB, (LAS float*)(F.lds + XCH_OFF)};
            pg8::gemm_phase<pg8::EpiResNorm, pg8::StaticOrder, true, true>(F.lds + RING_OFF, g, S, E); SEAM(pb + 6); }
    }
#undef IN
#undef SEAM
}

extern "C" void kernel_launch(void* const* d_in, const int* in_sizes, int n_in, void* d_out, int out_size, void* d_ws, size_t ws_size, hipStream_t stream) {
    static int grid = 0;
    if (grid == 0) {
        if (n_in != 13 || in_sizes[0] != M * DM || out_size != M * DM || ws_size < WS_END) { fprintf(stderr, "kernel_launch: unexpected shapes (n_in %d, in0 %d, out %d, ws %zu; need ws >= %zu); nothing launched\n", n_in, n_in > 0 ? in_sizes[0] : -1, out_size, ws_size, (size_t)WS_END); grid = -1; return; }
        int dev = 0, cus = 0, per_cu = 0;
        if (hipGetDevice(&dev) != hipSuccess || hipDeviceGetAttribute(&cus, hipDeviceAttributeMultiprocessorCount, dev) != hipSuccess) { grid = -1; return; }
        if (hipFuncSetAttribute((const void*)mk_fwd, hipFuncAttributeMaxDynamicSharedMemorySize, LDS_BYTES) != hipSuccess) { fprintf(stderr, "kernel_launch: hipFuncSetAttribute failed\n"); grid = -1; return; }
        if (hipOccupancyMaxActiveBlocksPerMultiprocessor(&per_cu, (const void*)mk_fwd, NWAVES * 64, LDS_BYTES) != hipSuccess || per_cu < 1) fprintf(stderr, "kernel_launch: occupancy query reports %d workgroups per CU\n", per_cu);
        (void)hipGetLastError();
        grid = cus;
    }
    if (grid < 0) return;
    if (hipMemsetAsync((char*)d_ws + WS_CTL, 0, CTL_ZERO_BYTES, stream) != hipSuccess) return;
    Args a{};
    for (int i = 0; i < 13; ++i) a.in[i] = (const float*)d_in[i];
    a.out = (float*)d_out; a.ws = (unsigned char*)d_ws;
#if MK_SINGLE
    a.ph_lo = 0; a.ph_hi = NPHASES;
    hipLaunchKernelGGL(mk_fwd, dim3(grid), dim3(NWAVES * 64), LDS_BYTES, stream, a);
#else
    for (int p = 0; p < NPHASES; ++p) { a.ph_lo = p; a.ph_hi = p + 1; hipLaunchKernelGGL(mk_fwd, dim3(grid), dim3(NWAVES * 64), LDS_BYTES, stream, a); }
#endif
    const hipError_t le = hipPeekAtLastError();
    if (le != hipSuccess) fprintf(stderr, "kernel_launch: launch failed: %s\n", hipGetErrorName(le));
}
```

```cpp
#include <hip/hip_runtime.h>
#include <cstdio>
#include <cstdint>
#include <cmath>

constexpr int DM = 2048, NBATCH = 4, SEQ = 4096, M = NBATCH * SEQ, DEPTH = 4, HD = 128;
constexpr int NIN = 15360, DFF = 5632, NGU = 2 * DFF, KBR = 2560;
constexpr int OFF_QA = 0, OFF_KA = 1024, OFF_VA = 1280, OFF_QB = 1536, OFF_KB = 3072, OFF_VB = 4608, OFF_QC = 6144, OFF_KC = 7168, OFF_VC = 8192, OFF_G = 9216;
constexpr int OC_A = 0, OC_B = 1024, OC_C = 1536;
constexpr float NORM_EPS = 1e-6f;
constexpr float ATT_SCALE = 0.08838834764831845f;
constexpr int NWAVES = 8;

constexpr size_t MiB = 1u << 20;
constexpr size_t WS_CTL = 0, CTL_ZERO_BYTES = 65536;
constexpr size_t WS_ROPE = 1 * MiB;
constexpr size_t WS_W = 4 * MiB;
constexpr size_t LW_IN = 0, LW_BR = LW_IN + (size_t)NIN * DM * 2, LW_O = LW_BR + (size_t)DM * KBR * 2, LW_GU = LW_O + (size_t)DM * DM * 2,
                 LW_D = LW_GU + (size_t)NGU * DM * 2, LW_SZ = LW_D + (size_t)DM * DFF * 2;
static_assert(LW_SZ == 144 * MiB, "per-layer bf16 weights");
constexpr size_t WS_XN = WS_W + DEPTH * LW_SZ;
constexpr size_t WS_PROJ = WS_XN + (size_t)M * DM * 2;
constexpr size_t WS_HID = WS_PROJ;
constexpr size_t WS_OCAT = WS_PROJ + (size_t)M * NIN * 2;
constexpr size_t WS_MRG = WS_OCAT + (size_t)M * KBR * 2;
constexpr size_t WS_MACC = WS_MRG + (size_t)M * DM * 2;
constexpr size_t WS_OB = WS_MACC + (size_t)M * DM * 4;
constexpr size_t WS_LB = WS_OB + (size_t)3 * M * 512 * 2;
constexpr size_t WS_SSQ = WS_LB + (size_t)3 * M * 4 * 4;
constexpr size_t WS_XLO = WS_SSQ + (size_t)M * 8 * 4;
constexpr size_t WS_END = WS_XLO + (size_t)M * DM * 2;
constexpr int CW_SPLIT = 8192;
constexpr int CW_BAR = 4096;

constexpr int RING_OFF = 0, RING_BYTES = 131072;
constexpr int XCH_OFF = RING_BYTES, RS_OFF = RING_BYTES + 8192;
constexpr int MISC_OFF = RING_BYTES + 16384;
constexpr int LDS_BYTES = 151552;

#define GAS __attribute__((address_space(1)))
#define LAS __attribute__((address_space(3)))
typedef unsigned short bf16;
typedef unsigned v4u __attribute__((ext_vector_type(4)));
typedef unsigned v2u __attribute__((ext_vector_type(2)));
typedef float f32x4 __attribute__((ext_vector_type(4)));
typedef float f32x2 __attribute__((ext_vector_type(2)));
typedef short bf16x8 __attribute__((ext_vector_type(8)));
typedef _Float16 h16x2 __attribute__((ext_vector_type(2)));

__device__ __forceinline__ unsigned cvt_pk_bf16(float lo, float hi) { unsigned r; asm volatile("v_cvt_pk_bf16_f32 %0, %1, %2" : "=v"(r) : "v"(lo), "v"(hi)); return r; }
__device__ __forceinline__ unsigned cvt_pk_f16(float lo, float hi) { h16x2 h = {(_Float16)lo, (_Float16)hi}; return __builtin_bit_cast(unsigned, h); }
__device__ __forceinline__ float bf_lo(unsigned u) { return __uint_as_float(u << 16); }
__device__ __forceinline__ float bf_hi(unsigned u) { return __uint_as_float(u & 0xffff0000u); }
__device__ __forceinline__ float h_lo(unsigned u) { h16x2 h = __builtin_bit_cast(h16x2, u); return (float)h.x; }
__device__ __forceinline__ float h_hi(unsigned u) { h16x2 h = __builtin_bit_cast(h16x2, u); return (float)h.y; }
template <int CTRL> __device__ __forceinline__ float dpp_f(float v) { return __builtin_bit_cast(float, __builtin_amdgcn_update_dpp(0, __builtin_bit_cast(int, v), CTRL, 0xf, 0xf, true)); }
__device__ __forceinline__ float lane_xor1(float v) { return dpp_f<0xB1>(v); }
__device__ __forceinline__ float lane_xor2(float v) { return dpp_f<0x4E>(v); }
__device__ __forceinline__ float lane_xor16(float v) { return __builtin_bit_cast(float, __builtin_amdgcn_ds_swizzle(__builtin_bit_cast(int, v), (0x10 << 10) | 0x1f)); }
__device__ __forceinline__ float add_xor32(float v) { auto rr = __builtin_amdgcn_permlane32_swap(__float_as_uint(v), __float_as_uint(v), false, false); return __uint_as_float(rr[0]) + __uint_as_float(rr[1]); }
__device__ __forceinline__ float wave_sum(float v) {
    v += lane_xor1(v); v += lane_xor2(v); v += dpp_f<0x141>(v)  ; v += dpp_f<0x140>(v)  ; v += lane_xor16(v);
    return add_xor32(v);
}
__device__ __forceinline__ float sigmoidf_fast(float x) { return __builtin_amdgcn_rcpf(1.0f + __builtin_amdgcn_exp2f(-1.4426950408889634f * x)); }

__host__ __device__ inline int slot32_v(int c32) { return 16 * ((c32 >> 2) & 1) + 4 * (c32 >> 3) + (c32 & 3); }
__host__ __device__ inline int slot128_qk(int d) { const int n = d >> 6, dlo = d & 63; return 32 * (dlo >> 4) + 16 * n + 4 * ((dlo >> 2) & 3) + (dlo & 3); }
__host__ __device__ inline bool is_qk_col(int n) { return n < OFF_VA || (n >= OFF_QB && n < OFF_VB) || (n >= OFF_QC && n < OFF_VC); }
enum { MAP_NAT = 0, MAP_V = 1, MAP_IN = 2, MAP_GU = 3 };
template <int MAP> __host__ __device__ inline int map_row(int n) {
    if (MAP == MAP_NAT) return n;
    if (MAP == MAP_V) return (n & ~31) + slot32_v(n & 31);
    if (MAP == MAP_IN) return is_qk_col(n) ? (n & ~127) + slot128_qk(n & 127) : (n & ~31) + slot32_v(n & 31);
    const int up = n >= DFF ? 1 : 0, jh = n - up * DFF; return 256 * (jh >> 7) + 128 * up + (jh & 96) + slot32_v(jh & 31);
}
#define XB_TMO      128
#define XB_XCNT(j)  (256  + 64 * (j))
#define XB_XSUB(j)  (1280 + 64 * (j))
#define XB_XGEN(j)  (2304 + 64 * (j))
#define XB_TOP      3328
#define XB_TOPGEN   3392
#define XCD_BAR_WORDS 3456
#define XB_SPIN_CAP (1u << 18)

__device__ __forceinline__ unsigned xb_ld(unsigned* p)              { return __hip_atomic_load(p, __ATOMIC_RELAXED, __HIP_MEMORY_SCOPE_AGENT); }
__device__ __forceinline__ unsigned xb_add(unsigned* p, unsigned v) { return __hip_atomic_fetch_add(p, v, __ATOMIC_RELAXED, __HIP_MEMORY_SCOPE_AGENT); }
__device__ __forceinline__ unsigned xb_xcc_id() { return (unsigned)__builtin_amdgcn_s_getreg((3 << 11) | 20) & 0xFu; }
#define XB_SPIN(cond, bar) do { unsigned _sp = 0; while (cond) { __builtin_amdgcn_s_sleep(1); \
    if ((++_sp & 255u) == 0u) { if (xb_ld(&(bar)[XB_TMO])) break; if (_sp > XB_SPIN_CAP) { atomicAdd(&(bar)[XB_TMO], 1u); break; } } } } while (0)

struct XcdBarrier {
    unsigned* bar; unsigned x;
    volatile LAS unsigned* st;
};

__device__ __forceinline__ XcdBarrier xcd_barrier_post(unsigned* bar, volatile LAS unsigned* st) {
    XcdBarrier b; b.bar = bar; b.x = xb_xcc_id(); b.st = st;
    if (threadIdx.x == 0) (void)xb_add(&bar[XB_XCNT(b.x)], 1u);
    return b;
}
__device__ __forceinline__ void xcd_barrier_complete(unsigned* bar, unsigned x, unsigned& nloc, unsigned& nx) {
    const unsigned G = gridDim.x * gridDim.y * gridDim.z;
    unsigned sum, cnt, mine, sp = 0u;
    for (;;) {
        sum = 0u; cnt = 0u; mine = 0u;
#pragma unroll
        for (unsigned j = 0; j < 16; ++j) { const unsigned c = xb_ld(&bar[XB_XCNT(j)]); sum += c; cnt += (c > 0u) ? 1u : 0u; mine = (j == x) ? c : mine; }
        if (sum == G) break;
        __builtin_amdgcn_s_sleep(1);
        if ((++sp & 255u) == 0u) { if (xb_ld(&bar[XB_TMO])) break; if (sp > XB_SPIN_CAP) { atomicAdd(&bar[XB_TMO], 1u); break; } }
    }
    nloc = mine > 0u ? mine : 1u; nx = cnt > 0u ? cnt : 1u;
}

__device__ __forceinline__ void xcd_barrier(const XcdBarrier& b) {
    asm volatile("s_waitcnt vmcnt(0)" ::: "memory");
    __syncthreads();
    if (threadIdx.x == 0) {
        unsigned* bar; { __attribute__((address_space(1))) unsigned* bg_ = (__attribute__((address_space(1))) unsigned*)b.bar; asm volatile("" : "+s"(bg_)); bar = (unsigned*)bg_; }
        __builtin_amdgcn_s_waitcnt(0);
        unsigned bx = b.x; asm volatile("" : "+s"(bx));
        unsigned nloc = b.st[0], nx = b.st[1];
        if (nloc == 0u) { xcd_barrier_complete(bar, bx, nloc, nx); b.st[0] = nloc; b.st[1] = nx; }
        const unsigned old = xb_add(&bar[XB_XSUB(bx)], 1u);
        const unsigned gen = old / nloc;
        if (old + 1u == (gen + 1u) * nloc) {
            __builtin_amdgcn_fence(__ATOMIC_RELEASE, "agent");
            asm volatile("s_waitcnt vmcnt(0)" ::: "memory");
            const unsigned og = xb_add(&bar[XB_TOP], 1u);
            const unsigned tg = og / nx;
            if (og + 1u == (tg + 1u) * nx) xb_add(&bar[XB_TOPGEN], 1u);
            else XB_SPIN(xb_ld(&bar[XB_TOPGEN]) == tg, bar);
            __builtin_amdgcn_fence(__ATOMIC_ACQUIRE, "agent");
            xb_add(&bar[XB_XGEN(bx)], 1u);
            asm volatile("s_waitcnt vmcnt(0)" ::: "memory");
        } else {
            XB_SPIN(xb_ld(&bar[XB_XGEN(bx)]) == gen, bar);
            __builtin_amdgcn_fence(__ATOMIC_ACQUIRE, "agent");
            asm volatile("s_waitcnt vmcnt(0)" ::: "memory");
        }
    }
    __syncthreads();
}

__device__ __forceinline__ void xcd_split_arrive(const XcdBarrier& b, unsigned* cb) {
    asm volatile("s_waitcnt vmcnt(0)" ::: "memory");
    __syncthreads();
    if (threadIdx.x == 0) {
        __attribute__((address_space(1))) unsigned* cg_ = (__attribute__((address_space(1))) unsigned*)cb; asm volatile("" : "+s"(cg_)); unsigned* c = (unsigned*)cg_;
        unsigned bx = b.x; asm volatile("" : "+s"(bx));
        const unsigned nloc = b.st[0];
        const unsigned old = xb_add(&c[64u * bx], 1u);
        if (old + 1u == nloc) {
            __builtin_amdgcn_fence(__ATOMIC_RELEASE, "agent");
            asm volatile("s_waitcnt vmcnt(0)" ::: "memory");
            xb_add(&c[1024], 1u);
        }
    }
}
__device__ __forceinline__ void xcd_split_wait_t0(unsigned* cb, unsigned nx, unsigned* tmo) {
    __attribute__((address_space(1))) unsigned* cg_ = (__attribute__((address_space(1))) unsigned*)cb; asm volatile("" : "+s"(cg_)); unsigned* c = (unsigned*)cg_;
    XB_SPIN(xb_ld(&c[1024]) < nx, tmo);
    __builtin_amdgcn_fence(__ATOMIC_ACQUIRE, "agent");
    asm volatile("s_waitcnt vmcnt(0)" ::: "memory");
}
namespace pg8 {
#define PG8_LAS __attribute__((address_space(3)))
typedef unsigned short bf16_t;
constexpr int BM = 256, BK = 64, HALF = 128, HTB = HALF * BK * 2  , STAGE_BYTES = 8 * HTB, NXCD = 8, WGM = 8;
__host__ __device__ __forceinline__ int lds_byte(int r, int c) { const int st = (r >> 4) * 2 + (c >> 5), rr = r & 15, cc = c & 31, ob = rr * 64 + cc * 2; return st * 1024 + (ob ^ (((ob >> 9) & 1) << 5)); }
__host__ __device__ __forceinline__ void stage_rc(int b, int& R, int& C) { const int st = b / 1024, sb = b % 1024, swz = sb ^ (((sb >> 9) & 1) << 5); R = (st >> 1) * 16 + swz / 64; C = (st & 1) * 32 + (swz % 64) / 2; }
struct Unit { int pm, pn; };
struct Gemm { const bf16_t* A; const bf16_t* Bt; int lda, ldb, M, N, K; };
struct StaticOrder {
    int nM, nN, nwg, G, c;
    __host__ __device__ __forceinline__ void init(int M, int N, int G_, int c_) { nM = M / BM; nN = N / BM; nwg = nM * nN; G = G_; c = c_; }
    __host__ __device__ __forceinline__ bool next(int i, Unit& u) const {
        const long L = (long)i * G + c; if (L >= nwg) return false;
        int wgid = (int)L; { const int q = nwg / NXCD, r = nwg % NXCD, xcd = wgid % NXCD, off = wgid / NXCD; wgid = (xcd < r ? xcd * (q + 1) : r * (q + 1) + (xcd - r) * q) + off; }
        const int nig = WGM * nN, gid = wgid / nig, fm = gid * WGM, gsz = (nM - fm) < WGM ? (nM - fm) : WGM;
        u.pm = fm + ((wgid % nig) % gsz); u.pn = (wgid % nig) / gsz; return true;
    }
    __device__ __forceinline__ void a_ready(const Unit&) const {}
    __device__ __forceinline__ void done(const Unit&) const {}
};
template <class Epi, class Sched, bool ALIGN_EPI = false, bool SP2 = false>
__device__ __forceinline__ void gemm_phase(PG8_LAS unsigned char* lds, const Gemm g, const Sched& S, const Epi& E) {
    int tid = threadIdx.x; asm volatile("" : "+v"(tid));
    const int wid = __builtin_amdgcn_readfirstlane(tid >> 6), lane = tid & 63, wr = wid >> 2, wc = wid & 3, fr = lane & 15, fq = lane >> 4;
    const int K = g.K, nt = K / BK, lda = g.lda, ldb = g.ldb;
    unsigned voffA[2], voffB[2];
#pragma unroll
    for (int i = 0; i < 2; ++i) { int R, C; stage_rc(tid * 16 + i * 8192, R, C);
        voffA[i] = (unsigned)(R * lda + C) * 2u; voffB[i] = (unsigned)(R * ldb + C) * 2u; }
    const size_t kstep = (size_t)(BK * 2);
    const size_t hstepA = (size_t)HALF * lda * 2, hstepB = (size_t)HALF * ldb * 2;
    const size_t tstepA = 2 * hstepA, tstepB = 2 * hstepB;
    const unsigned ldsw = (unsigned)wid * 1024u;
    const int aoff = lds_byte(wr * 64 + fr, fq * 8), boff = lds_byte(wc * 32 + fr, fq * 8);
#define PG8_SA(b, h) (((b) * 2 + (h)) * HTB)
#define PG8_SB(b, h) ((4 + (b) * 2 + (h)) * HTB)
#define PG8_STAGE(bufoff, gbase, voff) do { _Pragma("unroll") for (int _i = 0; _i < 2; ++_i) \
        __builtin_amdgcn_global_load_lds((const unsigned*)((const char*)(gbase) + (voff)[_i]), (PG8_LAS unsigned*)(lds + (bufoff) + ldsw + _i * 8192), 16, 0, 0); } while (0)
#define PG8_LDA(dst, b, h) do { _Pragma("unroll") for (int m = 0; m < 4; ++m) _Pragma("unroll") for (int k = 0; k < 2; ++k) dst[m][k] = *(const PG8_LAS bf16x8*)(lds + PG8_SA(b, h) + aoff + m * 2048 + k * 1024); } while (0)
#define PG8_LDB(dst, b, h) do { _Pragma("unroll") for (int n = 0; n < 2; ++n) _Pragma("unroll") for (int k = 0; k < 2; ++k) dst[n][k] = *(const PG8_LAS bf16x8*)(lds + PG8_SB(b, h) + boff + n * 2048 + k * 1024); } while (0)
#define PG8_MMA(ai, bj, At, Bt) do { __builtin_amdgcn_s_setprio(1); _Pragma("unroll") for (int m = 0; m < 4; ++m) _Pragma("unroll") for (int n = 0; n < 2; ++n) _Pragma("unroll") for (int k = 0; k < 2; ++k) \
        acc[ai][bj][m][n] = __builtin_amdgcn_mfma_f32_16x16x32_bf16(Bt[n][k], At[m][k], acc[ai][bj][m][n], 0, 0, 0); __builtin_amdgcn_s_setprio(0); } while (0)
#define PG8_WAIT_V(n) asm volatile("s_waitcnt vmcnt(" #n ")" ::: "memory")
#define PG8_WAIT_L(n) asm volatile("s_waitcnt lgkmcnt(" #n ")" ::: "memory")
#define PG8_BAR __builtin_amdgcn_s_barrier()
#define PG8_SCHED __builtin_amdgcn_sched_barrier(0)
    Unit cur, nxt; int ui = 0;
    if (!S.next(0, cur)) return;
    f32x4 acc[2][2][4][2];
#pragma unroll
    for (int a = 0; a < 2; ++a)
#pragma unroll
        for (int b = 0; b < 2; ++b)
#pragma unroll
            for (int m = 0; m < 4; ++m)
#pragma unroll
                for (int n = 0; n < 2; ++n) acc[a][b][m][n] = (f32x4){0.f, 0.f, 0.f, 0.f};
    bf16x8 At[4][2], B0[2][2], B1[2][2];
    int k0 = 0; if constexpr (Epi::KPERM) k0 = E.seg_first(0) * (int)(BK * 2);
    const char* cA = (const char*)g.A + (size_t)cur.pm * tstepA + k0; const char* cB = (const char*)g.Bt + (size_t)cur.pn * tstepB + k0;
    S.a_ready(cur);
    if constexpr (SP2) {
        PG8_STAGE(PG8_SB(0, 0), cB, voffB); PG8_STAGE(PG8_SB(0, 1), cB + hstepB, voffB); PG8_STAGE(PG8_SA(0, 0), cA, voffA); PG8_STAGE(PG8_SA(0, 1), cA + hstepA, voffA);
        if (wr == 1) PG8_BAR;
        PG8_WAIT_V(2); PG8_BAR;
        E.pro();
        PG8_STAGE(PG8_SB(1, 0), cB + kstep, voffB); PG8_STAGE(PG8_SA(1, 0), cA + kstep, voffA); PG8_STAGE(PG8_SB(1, 1), cB + hstepB + kstep, voffB);
        PG8_WAIT_V(6); PG8_BAR;
    } else {
        PG8_STAGE(PG8_SB(0, 0), cB, voffB); PG8_STAGE(PG8_SA(0, 0), cA, voffA); PG8_STAGE(PG8_SB(0, 1), cB + hstepB, voffB); PG8_STAGE(PG8_SA(0, 1), cA + hstepA, voffA);
        if (wr == 1) PG8_BAR;
        PG8_WAIT_V(4); PG8_BAR;
        PG8_STAGE(PG8_SB(1, 0), cB + kstep, voffB); PG8_STAGE(PG8_SA(1, 0), cA + kstep, voffA); PG8_STAGE(PG8_SB(1, 1), cB + hstepB + kstep, voffB);
        PG8_WAIT_V(6); PG8_BAR;
    }
    for (;;) {
        const bool has_next = S.next(ui + 1, nxt);
        const char* nA = has_next ? (const char*)g.A + (size_t)nxt.pm * tstepA + k0 : cA; const char* nB = has_next ? (const char*)g.Bt + (size_t)nxt.pn * tstepB + k0 : cB;
#pragma unroll
        for (int sg = 0; sg < Epi::NSEG; ++sg) {
        int t_lo, t_hi, dk = 0, dkn = 0;
        if constexpr (Epi::KPERM) { t_lo = sg == 0 ? 0 : E.seg_end(sg - 1); t_hi = sg == Epi::NSEG - 1 ? nt : E.seg_end(sg);
            dk = (E.seg_first(sg) - t_lo) * (int)(BK * 2) - k0; if (sg + 1 < Epi::NSEG) dkn = (E.seg_first(sg + 1) - t_hi) * (int)(BK * 2) - k0; }
        else { t_lo = sg == 0 ? 0 : Epi::SEG_END[sg - 1]; t_hi = sg == Epi::NSEG - 1 ? nt : Epi::SEG_END[sg]; }
        for (int t = t_lo; t < t_hi; t += 2) {
            const bool last = (t == nt - 2);
            const int d2 = (t + 2 == t_hi) ? dkn : dk;
            const char* a1 = cA + (long)((t + 1) * (int)(BK * 2) + dk);
            const char* a2 = last ? nA : cA + (long)((t + 2) * (int)(BK * 2) + d2); const char* b2 = last ? nB : cB + (long)((t + 2) * (int)(BK * 2) + d2);
            const char* a3 = a2 + kstep; const char* b3 = b2 + kstep;
            if (last && has_next) S.a_ready(nxt);
            if constexpr (SP2) {
            PG8_LDB(B0, 0, 0); PG8_LDB(B1, 0, 1); PG8_SCHED; PG8_LDA(At, 0, 0); PG8_STAGE(PG8_SA(1, 1), a1 + hstepA, voffA);
            PG8_WAIT_V(8); PG8_WAIT_L(0); PG8_BAR; PG8_MMA(0, 0, At, B0); PG8_MMA(0, 1, At, B1); PG8_BAR; PG8_SCHED;
            PG8_LDA(At, 0, 1); PG8_STAGE(PG8_SB(0, 0), b2, voffB); PG8_STAGE(PG8_SB(0, 1), b2 + hstepB, voffB); PG8_STAGE(PG8_SA(0, 0), a2, voffA);
            PG8_WAIT_V(8); PG8_WAIT_L(0); PG8_BAR; PG8_MMA(1, 0, At, B0); PG8_MMA(1, 1, At, B1); PG8_BAR; PG8_SCHED;
            PG8_LDB(B0, 1, 0); PG8_LDB(B1, 1, 1); PG8_SCHED; PG8_LDA(At, 1, 0); PG8_STAGE(PG8_SA(0, 1), a2 + hstepA, voffA);
            PG8_WAIT_V(8); PG8_WAIT_L(0); PG8_BAR; PG8_MMA(0, 0, At, B0); PG8_MMA(0, 1, At, B1); PG8_BAR; PG8_SCHED;
            PG8_LDA(At, 1, 1); PG8_STAGE(PG8_SB(1, 0), b3, voffB); PG8_STAGE(PG8_SB(1, 1), b3 + hstepB, voffB); PG8_STAGE(PG8_SA(1, 0), a3, voffA);
            PG8_WAIT_V(8); PG8_WAIT_L(0); PG8_BAR; PG8_MMA(1, 0, At, B0); PG8_MMA(1, 1, At, B1); PG8_BAR; PG8_SCHED;
            } else {
            PG8_LDB(B0, 0, 0); PG8_SCHED; PG8_LDA(At, 0, 0); PG8_STAGE(PG8_SA(1, 1), a1 + hstepA, voffA);
            PG8_WAIT_L(8); PG8_BAR; PG8_WAIT_L(0); PG8_MMA(0, 0, At, B0); PG8_BAR; PG8_SCHED;
            PG8_LDB(B1, 0, 1); PG8_STAGE(PG8_SB(0, 0), b2, voffB);
            PG8_BAR; PG8_WAIT_L(0); PG8_MMA(0, 1, At, B1); PG8_BAR;
            PG8_LDA(At, 0, 1); PG8_STAGE(PG8_SA(0, 0), a2, voffA);
            PG8_BAR; PG8_WAIT_L(0); PG8_MMA(1, 0, At, B0); PG8_BAR; PG8_SCHED;
            PG8_STAGE(PG8_SB(0, 1), b2 + hstepB, voffB);
            PG8_WAIT_V(6); PG8_BAR; PG8_MMA(1, 1, At, B1); PG8_BAR;
            PG8_LDB(B0, 1, 0); PG8_SCHED; PG8_LDA(At, 1, 0); PG8_STAGE(PG8_SA(0, 1), a2 + hstepA, voffA);
            PG8_WAIT_L(8); PG8_BAR; PG8_WAIT_L(0); PG8_MMA(0, 0, At, B0); PG8_BAR; PG8_SCHED;
            PG8_LDB(B1, 1, 1); PG8_STAGE(PG8_SB(1, 0), b3, voffB);
            PG8_BAR; PG8_WAIT_L(0); PG8_MMA(0, 1, At, B1); PG8_BAR;
            PG8_LDA(At, 1, 1); PG8_STAGE(PG8_SA(1, 0), a3, voffA);
            PG8_BAR; PG8_WAIT_L(0); PG8_MMA(1, 0, At, B0); PG8_BAR; PG8_SCHED;
            PG8_STAGE(PG8_SB(1, 1), b3 + hstepB, voffB);
            PG8_WAIT_V(6); PG8_BAR; PG8_MMA(1, 1, At, B1); PG8_BAR;
            }
        }
        if constexpr (Epi::NSEG > 1) { if (sg + 1 < Epi::NSEG) E.mid(acc, cur, sg, wr, wc, fr, fq); }
        }
        if constexpr (ALIGN_EPI) { if (wr == 0) PG8_BAR; }
        if constexpr (!Epi::AFTER_DRAIN) { E(acc, cur, wr, wc, fr, fq); S.done(cur); }
        if (!has_next) break;
#pragma unroll
        for (int a = 0; a < 2; ++a)
#pragma unroll
            for (int b = 0; b < 2; ++b)
#pragma unroll
                for (int m = 0; m < 4; ++m)
#pragma unroll
                    for (int n = 0; n < 2; ++n) { f32x2 z0_, z1_; asm("v_mov_b64 %0, 0" : "=v"(z0_)); asm("v_mov_b64 %0, 0" : "=v"(z1_)); acc[a][b][m][n] = (f32x4){z0_[0], z0_[1], z1_[0], z1_[1]}; }
        cur = nxt; cA = nA; cB = nB; ++ui;
        if constexpr (ALIGN_EPI) { if (wr == 1) PG8_BAR; }
    }
    PG8_WAIT_V(0);
    if constexpr (!ALIGN_EPI) { if (wr == 0) PG8_BAR; }
    PG8_BAR;
    if constexpr (Epi::AFTER_DRAIN) { E.fused(acc, cur, wr, wc, fr, fq, lds, wid, lane); S.done(cur); }
#undef PG8_SA
#undef PG8_SB
#undef PG8_STAGE
#undef PG8_LDA
#undef PG8_LDB
#undef PG8_MMA
#undef PG8_WAIT_V
#undef PG8_WAIT_L
#undef PG8_BAR
#undef PG8_SCHED
}
}
namespace pg8 {
constexpr size_t PROJ_GATE0 = (size_t)72 * M * 128;
__device__ __forceinline__ size_t proj_qkv_off(int hh, int row) { return ((size_t)hh * M + row) * 128; }
__device__ __forceinline__ size_t proj_gate_off(int pnp, int pm, int row_local, int col_local) { return PROJ_GATE0 + ((size_t)(pnp * (M / BM) + pm) * BM + row_local) * BM + col_local; }
__device__ __forceinline__ float gate_val(float x) { return fminf(__builtin_amdgcn_exp2f(-1.4426950408889634f * x), 65504.0f); }
struct EpiProj {
    static constexpr bool AFTER_DRAIN = false; static constexpr bool KPERM = false; static constexpr int NSEG = 1; static constexpr int SEG_END[1] = {0};
    __device__ __forceinline__ void pro() const {
#pragma unroll
        for (int i = 0; i < 4; ++i) { const f32x4 s0 = rsv[i][0], s1 = rsv[i][1];
            ((PG8_LAS float*)RS)[threadIdx.x + i * 512] = __builtin_amdgcn_rsqf((((s0[0] + s0[1]) + (s0[2] + s0[3])) + ((s1[0] + s1[1]) + (s1[2] + s1[3]))) * (1.0f / DM) + NORM_EPS); }
    }
    bf16_t* P; const float* qkg  ; const unsigned* rope  ; PG8_LAS float* X  ;
    const PG8_LAS float* RS  ;
    f32x4 rsv[4][2];
    __device__ __forceinline__ void operator()(const f32x4 (&acc)[2][2][4][2], const Unit& u, int wr, int wc, int fr, int fq) const {
        int row0 = u.pm * BM + wr * 64 + fr, col0 = u.pn * BM + wc * 32 + 8 * fq; const int pn = u.pn;
        asm volatile("" : "+v"(row0), "+v"(col0));
        const bool gate = pn >= OFF_G / BM;
        const bool qk = pn < 5 || (pn >= 6 && pn < 18) || (pn >= 24 && pn < 32);
        float rsx[2][4];
#pragma unroll
        for (int ai = 0; ai < 2; ++ai)
#pragma unroll
            for (int m = 0; m < 4; ++m) rsx[ai][m] = RS[(u.pm & 7) * BM + ai * HALF + wr * 64 + m * 16 + fr];
        if (qk) {
            const int gi = pn < 4 ? 0 : (pn == 4 ? 1 : (pn < 12 ? 2 : (pn < 18 ? 3 : (pn < 28 ? 4 : 5))));
#pragma unroll
            for (int ai = 0; ai < 2; ++ai)
#pragma unroll
                for (int m = 0; m < 4; ++m)
#pragma unroll
                    for (int bj = 0; bj < 2; ++bj) { const f32x4 v0 = acc[ai][bj][m][0] * rsx[ai][m], v1 = acc[ai][bj][m][1] * rsx[ai][m];
                        float s = (v0[0] * v0[0] + v0[1] * v0[1]) + (v0[2] * v0[2] + v0[3] * v0[3]) + (v1[0] * v1[0] + v1[1] * v1[1]) + (v1[2] * v1[2] + v1[3] * v1[3]);
                        s += lane_xor16(s); s = add_xor32(s);
                        if (fq == 0) X[(ai * HALF + wr * 64 + m * 16 + fr) * 8 + bj * 4 + wc] = s; }
            const f32x4 ga = *(const f32x4*)(qkg + gi * HD + 16 * wc + 4 * fq), gb = *(const f32x4*)(qkg + gi * HD + 64 + 16 * wc + 4 * fq);
            v4u rc[2][4];
            if (gi < 4) {
#pragma unroll
                for (int ai = 0; ai < 2; ++ai)
#pragma unroll
                    for (int m = 0; m < 4; ++m) { const int r = row0 + ai * HALF + m * 16; rc[ai][m] = *(const v4u*)(rope + (size_t)(r & (SEQ - 1)) * 64 + 16 * wc + 4 * fq); }
            }
            asm volatile("s_waitcnt lgkmcnt(0)" ::: "memory"); __builtin_amdgcn_s_barrier(); asm volatile("" ::: "memory");
#pragma unroll
            for (int ai = 0; ai < 2; ++ai)
#pragma unroll
                for (int m = 0; m < 4; ++m) { const int r = row0 + ai * HALF + m * 16; bf16_t* rowp = P + proj_qkv_off(2 * pn, r) + (col0 & 255);
                    f32x2 cs[4];
                    if (gi < 4) { const v4u c = rc[ai][m];
                        cs[0] = (f32x2){h_lo(c.x), h_hi(c.x)}; cs[1] = (f32x2){h_lo(c.y), h_hi(c.y)}; cs[2] = (f32x2){h_lo(c.z), h_hi(c.z)}; cs[3] = (f32x2){h_lo(c.w), h_hi(c.w)}; }
#pragma unroll
                    for (int bj = 0; bj < 2; ++bj) { const f32x4 t = *(const PG8_LAS f32x4*)(X + (ai * HALF + wr * 64 + m * 16 + fr) * 8 + bj * 4);
                        const float rs = rsx[ai][m] * __builtin_amdgcn_rsqf(((t[0] + t[1]) + (t[2] + t[3])) * (1.0f / HD) + NORM_EPS);
                        f32x4 a = acc[ai][bj][m][0] * rs * ga, b = acc[ai][bj][m][1] * rs * gb;
                        if (gi < 4) {
#pragma unroll
                            for (int j = 0; j < 4; ++j) { const float x1 = a[j], x2 = b[j]; a[j] = x1 * cs[j].x - x2 * cs[j].y; b[j] = x2 * cs[j].x + x1 * cs[j].y; } }
                        v4u w; w.x = cvt_pk_bf16(a[0], a[1]); w.y = cvt_pk_bf16(a[2], a[3]); w.z = cvt_pk_bf16(b[0], b[1]); w.w = cvt_pk_bf16(b[2], b[3]);
                        *(v4u*)(rowp + (size_t)bj * M * 128) = w; } }
            return;
        }
        if (gate) {
#pragma unroll
            for (int ai = 0; ai < 2; ++ai)
#pragma unroll
                for (int m = 0; m < 4; ++m) { const int rg_ = row0 + ai * HALF + m * 16, cl_ = col0 & 255; bf16_t* rowp = P + proj_gate_off(pn - OFF_G / BM, u.pm, rg_ & 255, cl_);
#pragma unroll
                    for (int bj = 0; bj < 2; ++bj) { const f32x4 v0 = acc[ai][bj][m][0] * rsx[ai][m], v1 = acc[ai][bj][m][1] * rsx[ai][m]; v4u w;
                        w.x = cvt_pk_f16(gate_val(v0[0]), gate_val(v0[1])); w.y = cvt_pk_f16(gate_val(v0[2]), gate_val(v0[3]));
                        w.z = cvt_pk_f16(gate_val(v1[0]), gate_val(v1[1])); w.w = cvt_pk_f16(gate_val(v1[2]), gate_val(v1[3]));
                        *(v4u*)(rowp + bj * HALF) = w; } }
            return;
        }
#pragma unroll
        for (int ai = 0; ai < 2; ++ai)
#pragma unroll
            for (int m = 0; m < 4; ++m) { const int rg_ = row0 + ai * HALF + m * 16, cl_ = col0 & 255; bf16_t* rowp = P + proj_qkv_off(2 * pn, rg_) + cl_;
#pragma unroll
                for (int bj = 0; bj < 2; ++bj) { const f32x4 v0 = acc[ai][bj][m][0] * rsx[ai][m], v1 = acc[ai][bj][m][1] * rsx[ai][m]; v4u w;
                    w.x = cvt_pk_bf16(v0[0], v0[1]); w.y = cvt_pk_bf16(v0[2], v0[3]); w.z = cvt_pk_bf16(v1[0], v1[1]); w.w = cvt_pk_bf16(v1[2], v1[3]);
                    *(v4u*)(rowp + (size_t)bj * M * 128) = w; } }
    }
};
template <int MODE> struct EpiGateAcc {
    static constexpr bool AFTER_DRAIN = false; static constexpr bool KPERM = false; static constexpr int NSEG = 1; static constexpr int SEG_END[1] = {0};
    __device__ __forceinline__ void pro() const {}
    const bf16_t* G; float* macc; bf16_t* mrg;
    __device__ __forceinline__ void operator()(const f32x4 (&acc)[2][2][4][2], const Unit& u, int wr, int wc, int fr, int fq) const {
        const int row0 = u.pm * BM + wr * 64 + fr, col0 = u.pn * BM + wc * 32 + 8 * fq;
#pragma unroll
        for (int ai = 0; ai < 2; ++ai)
#pragma unroll
            for (int m = 0; m < 4; ++m) { const int r = row0 + ai * HALF + m * 16;
#pragma unroll
                for (int bj = 0; bj < 2; ++bj) { const int c = col0 + bj * HALF;
                    const v4u gw = *(const v4u*)(G + (size_t)r * NIN + c);
                    f32x4 a0 = acc[ai][bj][m][0], a1 = acc[ai][bj][m][1];
                    a0[0] *= h_lo(gw.x); a0[1] *= h_hi(gw.x); a0[2] *= h_lo(gw.y); a0[3] *= h_hi(gw.y);
                    a1[0] *= h_lo(gw.z); a1[1] *= h_hi(gw.z); a1[2] *= h_lo(gw.w); a1[3] *= h_hi(gw.w);
                    float* mp = macc + (size_t)r * DM + c;
                    if (MODE >= 1) { a0 += *(const f32x4*)mp; a1 += *(const f32x4*)(mp + 4); }
                    if (MODE <= 1) { *(f32x4*)mp = a0; *(f32x4*)(mp + 4) = a1; }
                    else { v4u w; w.x = cvt_pk_bf16(a0[0], a0[1]); w.y = cvt_pk_bf16(a0[2], a0[3]); w.z = cvt_pk_bf16(a1[0], a1[1]); w.w = cvt_pk_bf16(a1[2], a1[3]);
                           *(v4u*)(mrg + (size_t)r * DM + c) = w; } } }
    }
};
struct EpiResNorm {
    static constexpr bool AFTER_DRAIN = false; static constexpr bool KPERM = false; static constexpr int NSEG = 1; static constexpr int SEG_END[1] = {0};
    __device__ __forceinline__ void pro() const {}
    float* out_f32; bf16_t* hi; float* SSQ; PG8_LAS float* X;
    __device__ __forceinline__ void operator()(const f32x4 (&acc)[2][2][4][2], const Unit& u, int wr, int wc, int fr, int fq) const {
        const int row0 = u.pm * BM + wr * 64 + fr, col0 = u.pn * BM + wc * 32 + 8 * fq;
        v4u bv[2][4][2];
#pragma unroll
        for (int ai = 0; ai < 2; ++ai)
#pragma unroll
            for (int m = 0; m < 4; ++m)
#pragma unroll
                for (int bj = 0; bj < 2; ++bj) bv[ai][m][bj] = *(const v4u*)(hi + (size_t)(row0 + ai * HALF + m * 16) * DM + col0 + bj * HALF);
#pragma unroll
        for (int ai = 0; ai < 2; ++ai) {
#pragma unroll
            for (int m = 0; m < 4; ++m) { const size_t off = (size_t)(row0 + ai * HALF + m * 16) * DM + col0; float s = 0.f;
#pragma unroll
                for (int bj = 0; bj < 2; ++bj) { const v4u p = bv[ai][m][bj];
                    const f32x4 b0 = (f32x4){bf_lo(p.x), bf_hi(p.x), bf_lo(p.y), bf_hi(p.y)}, b1 = (f32x4){bf_lo(p.z), bf_hi(p.z), bf_lo(p.w), bf_hi(p.w)};
                    const f32x4 o0 = b0 + acc[ai][bj][m][0], o1 = b1 + acc[ai][bj][m][1];
                    if (out_f32) { *(f32x4*)(out_f32 + off + bj * HALF) = o0; *(f32x4*)(out_f32 + off + bj * HALF + 4) = o1; }
                    else { v4u h; h.x = cvt_pk_bf16(o0[0], o0[1]); h.y = cvt_pk_bf16(o0[2], o0[3]); h.z = cvt_pk_bf16(o1[0], o1[1]); h.w = cvt_pk_bf16(o1[2], o1[3]);
                        *(v4u*)(hi + off + bj * HALF) = h; }
                    s += ((o0[0] * o0[0] + o0[1] * o0[1]) + (o0[2] * o0[2] + o0[3] * o0[3])) + ((o1[0] * o1[0] + o1[1] * o1[1]) + (o1[2] * o1[2] + o1[3] * o1[3])); }
                s += lane_xor16(s); s = add_xor32(s);
                if (fq == 0) X[(ai * HALF + wr * 64 + m * 16 + fr) * 4 + wc] = s; }
            asm volatile("" ::: "memory");
        }
        asm volatile("s_waitcnt lgkmcnt(0)" ::: "memory"); __builtin_amdgcn_s_barrier(); asm volatile("" ::: "memory");
        const int t = threadIdx.x;
        if (t < BM) { const f32x4 p = *(const PG8_LAS f32x4*)(X + t * 4); SSQ[(size_t)(u.pm * BM + t) * 8 + u.pn] = (p[0] + p[1]) + (p[2] + p[3]); }
    }
};
struct EpiSwiglu {
    static constexpr bool AFTER_DRAIN = false; static constexpr bool KPERM = false; static constexpr int NSEG = 1; static constexpr int SEG_END[1] = {0};
    __device__ __forceinline__ void pro() const {
#pragma unroll
        for (int i = 0; i < 4; ++i) { const f32x4 s0 = rsv[i][0], s1 = rsv[i][1];
            ((PG8_LAS float*)RS)[threadIdx.x + i * 512] = __builtin_amdgcn_rsqf((((s0[0] + s0[1]) + (s0[2] + s0[3])) + ((s1[0] + s1[1]) + (s1[2] + s1[3]))) * (1.0f / DM) + NORM_EPS); }
    }
    bf16_t* H; const PG8_LAS float* RS;
    f32x4 rsv[4][2];
    __device__ __forceinline__ void operator()(const f32x4 (&acc)[2][2][4][2], const Unit& u, int wr, int wc, int fr, int fq) const {
        const int row0 = u.pm * BM + wr * 64 + fr, col0 = u.pn * HALF + wc * 32 + 8 * fq;
        float rsx[2][4];
#pragma unroll
        for (int ai = 0; ai < 2; ++ai)
#pragma unroll
            for (int m = 0; m < 4; ++m) rsx[ai][m] = RS[(u.pm & 7) * BM + ai * HALF + wr * 64 + m * 16 + fr];
#pragma unroll
        for (int ai = 0; ai < 2; ++ai)
#pragma unroll
            for (int m = 0; m < 4; ++m) { float h[8]; const float rs = rsx[ai][m];
#pragma unroll
                for (int n = 0; n < 2; ++n)
#pragma unroll
                    for (int j = 0; j < 4; ++j) { const float g = acc[ai][0][m][n][j] * rs, up = acc[ai][1][m][n][j] * rs; h[4 * n + j] = g * sigmoidf_fast(g) * up; }
                v4u w; w.x = cvt_pk_bf16(h[0], h[1]); w.y = cvt_pk_bf16(h[2], h[3]); w.z = cvt_pk_bf16(h[4], h[5]); w.w = cvt_pk_bf16(h[6], h[7]);
                *(v4u*)(H + (size_t)(row0 + ai * HALF + m * 16) * DFF + col0) = w; }
    }
};
struct EpiBranch {
    static constexpr bool AFTER_DRAIN = false; static constexpr bool KPERM = true; static constexpr int NSEG = 3; static constexpr int SEG_END[3] = {16, 32, KBR / BK};
    __device__ __forceinline__ void pro() const {}
    unsigned char* ws; int layer; volatile PG8_LAS unsigned* st;
    __device__ __forceinline__ const bf16_t* Gp() const { return (const bf16_t*)(ws + WS_PROJ); }
    __device__ __forceinline__ bf16_t* mrgp() const { return (bf16_t*)(ws + WS_MRG); }
    __device__ __forceinline__ int seg_end(int sg) const { return sg == 0 ? 16 : (sg == 1 ? 32 : 40); }
    __device__ __forceinline__ int seg_first(int sg) const { return sg == 0 ? 0 : (sg == 1 ? 24 : 16); }
    __device__ __forceinline__ void mid(f32x4 (&acc)[2][2][4][2], const Unit& u, int which, int wr, int wc, int fr, int fq) const {
        if (which == 0) {
            if (threadIdx.x == 0) { const unsigned tag = (unsigned)layer + 1u; if (st[8] != tag) { xcd_split_wait_t0((unsigned*)(ws + WS_CTL) + CW_SPLIT + layer * 2048, st[1], (unsigned*)(ws + WS_CTL) + CW_BAR); st[8] = tag; } }
            __builtin_amdgcn_s_barrier();
        }
        const int ia = which == 0 ? 0 : 2, ib = which == 0 ? 2 : 1;
        int rl0 = wr * 64 + fr, cl0 = wc * 32 + 8 * fq;
        asm volatile("" : "+v"(rl0), "+v"(cl0));
        const bf16_t* gta = Gp() + proj_gate_off(8 * ia + u.pn, u.pm, 0, 0); const bf16_t* gtb = Gp() + proj_gate_off(8 * ib + u.pn, u.pm, 0, 0);
        const unsigned lo0 = (unsigned)(rl0 * BM + cl0) * 2u;
#pragma unroll
        for (int ai = 0; ai < 2; ++ai) {
            v4u ga[4][2], gb[4][2];
#pragma unroll
            for (int m = 0; m < 4; ++m)
#pragma unroll
                for (int bj = 0; bj < 2; ++bj) {
                    const char* ba_ = (const char*)gta + ((ai * HALF + m * 16) * BM + bj * HALF) * 2; const char* bb_ = (const char*)gtb + ((ai * HALF + m * 16) * BM + bj * HALF) * 2;
                    asm volatile("global_load_dwordx4 %0, %1, %2" : "=v"(ga[m][bj]) : "v"(lo0), "s"(ba_) : "memory");
                    asm volatile("global_load_dwordx4 %0, %1, %2" : "=v"(gb[m][bj]) : "v"(lo0), "s"(bb_) : "memory"); }
            asm volatile("s_waitcnt vmcnt(0)" : "+v"(ga[0][0]), "+v"(ga[0][1]), "+v"(ga[1][0]), "+v"(ga[1][1]), "+v"(ga[2][0]), "+v"(ga[2][1]), "+v"(ga[3][0]), "+v"(ga[3][1]),
                                                 "+v"(gb[0][0]), "+v"(gb[0][1]), "+v"(gb[1][0]), "+v"(gb[1][1]), "+v"(gb[2][0]), "+v"(gb[2][1]), "+v"(gb[3][0]), "+v"(gb[3][1]) :: "memory");
#pragma unroll
            for (int m = 0; m < 4; ++m)
#pragma unroll
                for (int bj = 0; bj < 2; ++bj) { const v4u a = ga[m][bj], b = gb[m][bj]; f32x4 r0, r1;
#define GR_(ta, tb) ((1.0f + (tb)) * __builtin_amdgcn_rcpf(1.0f + (ta)))
                    r0[0] = GR_(h_lo(a.x), h_lo(b.x)); r0[1] = GR_(h_hi(a.x), h_hi(b.x)); r0[2] = GR_(h_lo(a.y), h_lo(b.y)); r0[3] = GR_(h_hi(a.y), h_hi(b.y));
                    r1[0] = GR_(h_lo(a.z), h_lo(b.z)); r1[1] = GR_(h_hi(a.z), h_hi(b.z)); r1[2] = GR_(h_lo(a.w), h_lo(b.w)); r1[3] = GR_(h_hi(a.w), h_hi(b.w));
#undef GR_
                    acc[ai][bj][m][0] *= r0; acc[ai][bj][m][1] *= r1; }
            asm volatile("" ::: "memory");
        }
    }
    __device__ __forceinline__ void operator()(const f32x4 (&acc)[2][2][4][2], const Unit& u, int wr, int wc, int fr, int fq) const {
        int row0 = u.pm * BM + wr * 64 + fr, col0 = u.pn * BM + wc * 32 + 8 * fq;
        asm volatile("" : "+v"(row0), "+v"(col0));
        v4u gw[2][4][2];
#pragma unroll
        for (int ai = 0; ai < 2; ++ai)
#pragma unroll
            for (int m = 0; m < 4; ++m)
#pragma unroll
                for (int bj = 0; bj < 2; ++bj) gw[ai][m][bj] = *(const v4u*)(Gp() + proj_gate_off(8 + u.pn, u.pm, (row0 & 255) + ai * HALF + m * 16, (col0 & 255) + bj * HALF));
#pragma unroll
        for (int ai = 0; ai < 2; ++ai)
#pragma unroll
            for (int m = 0; m < 4; ++m) { const int r = row0 + ai * HALF + m * 16;
#pragma unroll
                for (int bj = 0; bj < 2; ++bj) { const int c = col0 + bj * HALF; const v4u g = gw[ai][m][bj];
                    const f32x4 a0 = acc[ai][bj][m][0], a1 = acc[ai][bj][m][1]; v4u w;
#define SG_(t) __builtin_amdgcn_rcpf(1.0f + (t))
                    w.x = cvt_pk_bf16(a0[0] * SG_(h_lo(g.x)), a0[1] * SG_(h_hi(g.x))); w.y = cvt_pk_bf16(a0[2] * SG_(h_lo(g.y)), a0[3] * SG_(h_hi(g.y)));
                    w.z = cvt_pk_bf16(a1[0] * SG_(h_lo(g.z)), a1[1] * SG_(h_hi(g.z))); w.w = cvt_pk_bf16(a1[2] * SG_(h_lo(g.w)), a1[3] * SG_(h_hi(g.w)));
#undef SG_
                    *(v4u*)(mrgp() + (size_t)r * DM + c) = w; } }
    }
};
}
namespace att {
typedef short s16x4 __attribute__((ext_vector_type(4)));
typedef float f32x16 __attribute__((ext_vector_type(16)));
constexpr int KVBLK = 64, QBLK = 32, QB = 256;
constexpr int SHM_V = KVBLK * HD * 2, SHM_K = KVBLK * HD * 2;
constexpr int Q_OFF = 2 * SHM_V + 2 * SHM_K;
constexpr int WS_OFF = Q_OFF + 8 * 8192;
constexpr int BIAS_OFF = WS_OFF + NWAVES * 64 * 4;
constexpr int ATT_LDS = BIAS_OFF + 2048;
constexpr float C2 = 1.4426950408889634f * ATT_SCALE;
constexpr float THR = 8.f;
#define KSWZ(row, colB) ((row) * 256 + ((colB) ^ (((row) & 7) << 4)))
#define SBAR() __builtin_amdgcn_sched_barrier(0)
__device__ __forceinline__ int v_st(int k, int c) { const int kk = (k & ~0xC) | ((k & 4) << 1) | ((k & 8) >> 1); return ((kk >> 3) * 4 + (c >> 5)) * 512 + ((kk & 7) * 32 + (c & 31)) * 2; }
__device__ __forceinline__ int v_rd_base(int lane) { return ((lane & 3) << 3) | (((lane >> 2) & 3) << 6) | (((lane >> 4) & 1) << 5) | (((lane >> 5) & 1) << 8); }
constexpr int v_rd_off(int d0, int ks, int half) { return d0 * 512 + ks * 4096 + half * 2048; }
__device__ __forceinline__ int crow(int r, int hi) { return (r & 3) + 8 * (r >> 2) + 4 * hi; }
__device__ __forceinline__ void partialSM(f32x16& p0, f32x16& p1, float& m_reg, float& mn, float& alpha) {
    float pmax = p0[0];
#pragma unroll
    for (int r = 1; r < 16; ++r) pmax = fmaxf(pmax, p0[r]);
#pragma unroll
    for (int r = 0; r < 16; ++r) pmax = fmaxf(pmax, p1[r]);
    { auto rr = __builtin_amdgcn_permlane32_swap(__float_as_uint(pmax), __float_as_uint(pmax), false, false);
      pmax = fmaxf(__uint_as_float(rr[0]), __uint_as_float(rr[1])); }
    if (__builtin_expect(__all((pmax - m_reg) * ATT_SCALE <= THR), 1)) { mn = m_reg; alpha = 1.f; }
    else { mn = fmaxf(m_reg, pmax); alpha = __builtin_amdgcn_exp2f((m_reg - mn) * C2); m_reg = mn; }
    const float mnL = -mn * C2;
#pragma unroll
    for (int r = 0; r < 16; ++r) p0[r] = __builtin_amdgcn_exp2f(fmaf(p0[r], C2, mnL));
#pragma unroll
    for (int r = 0; r < 16; ++r) p1[r] = fmaf(p1[r], C2, mnL);
}
__device__ __forceinline__ void finishSM(f32x16& p0, f32x16& p1, float alpha, float& l_reg, bf16x8& pa0, bf16x8& pa1, bf16x8& pa2, bf16x8& pa3) {
#pragma unroll
    for (int r = 0; r < 16; ++r) p1[r] = __builtin_amdgcn_exp2f(p1[r]);
    float ps = 0;
#pragma unroll
    for (int r = 0; r < 16; ++r) ps += p0[r];
#pragma unroll
    for (int r = 0; r < 16; ++r) ps += p1[r];
    { auto rr = __builtin_amdgcn_permlane32_swap(__float_as_uint(ps), __float_as_uint(ps), false, false);
      ps = __uint_as_float(rr[0]) + __uint_as_float(rr[1]); }
    l_reg = l_reg * alpha + ps;
#define PK4(P, B_, OUT) do { unsigned a0 = cvt_pk_bf16(P[B_+0], P[B_+1]), a1 = cvt_pk_bf16(P[B_+2], P[B_+3]);                          \
        unsigned b0 = cvt_pk_bf16(P[B_+4], P[B_+5]), b1 = cvt_pk_bf16(P[B_+6], P[B_+7]);                                             \
        auto r0 = __builtin_amdgcn_permlane32_swap(a0, b0, false, false); auto r1 = __builtin_amdgcn_permlane32_swap(a1, b1, false, false); \
        v4u w = {r0[0], r1[0], r0[1], r1[1]}; OUT = __builtin_bit_cast(bf16x8, w); } while (0)
    PK4(p0, 0, pa0); PK4(p0, 8, pa1); PK4(p1, 0, pa2); PK4(p1, 8, pa3);
#undef PK4
}
template <int KB>
__device__ __forceinline__ void qkt(f32x16& p0, f32x16& p1, const char* K_lds, int r32, int hi, const char* ql, bool act) {
    if (!act) { const float NEG = -__builtin_inff();
#pragma unroll
        for (int r = 0; r < 16; ++r) { p0[r] = NEG; p1[r] = NEG; } return; }
    p0 = f32x16{}; p1 = f32x16{};
    const char* kb[4];
#pragma unroll
    for (int dd = 0; dd < 4; ++dd) kb[dd] = K_lds + KB * SHM_K + KSWZ(r32, (dd * 16 + hi * 8) * 2);
#pragma unroll
    for (int d0 = 0; d0 < 8; ++d0) { const char* a = kb[d0 & 3] + (d0 >> 2) * 128;
        bf16x8 b0 = *reinterpret_cast<const bf16x8*>(a);
        bf16x8 b1 = *reinterpret_cast<const bf16x8*>(a + 32 * 256);
        const bf16x8 qv = *reinterpret_cast<const bf16x8*>(ql + d0 * 8192);
        p0 = __builtin_amdgcn_mfma_f32_32x32x16_bf16(b0, qv, p0, 0, 0, 0);
        p1 = __builtin_amdgcn_mfma_f32_32x32x16_bf16(b1, qv, p1, 0, 0, 0); }
}
template <int VB>
__device__ __forceinline__ void pv_tile(f32x16* o, int vb0, bf16x8 pa0, bf16x8 pa1, bf16x8 pa2, bf16x8 pa3, bool act) {
    if (!act) return;
#define TRRD(dst, off) asm volatile("ds_read_b64_tr_b16 %0, %1 offset:%2" : "=&v"(dst) : "v"(vb0), "i"(off) : "memory")
#define PV_D0(d0) do { s16x4 l0, l1, l2, l3, h0, h1, h2, h3; constexpr int b_ = VB * SHM_V + v_rd_off(d0, 0, 0);     \
        TRRD(l0, b_); TRRD(h0, b_ + 2048); TRRD(l1, b_ + 4096); TRRD(h1, b_ + 6144); TRRD(l2, b_ + 8192); TRRD(h2, b_ + 10240); TRRD(l3, b_ + 12288); TRRD(h3, b_ + 14336); \
        asm volatile("s_waitcnt lgkmcnt(0)" ::: "memory"); SBAR();                                                     \
        o[d0] = __builtin_amdgcn_mfma_f32_32x32x16_bf16(pa0, (bf16x8){l0[0], l0[1], l0[2], l0[3], h0[0], h0[1], h0[2], h0[3]}, o[d0], 0, 0, 0);   \
        o[d0] = __builtin_amdgcn_mfma_f32_32x32x16_bf16(pa1, (bf16x8){l1[0], l1[1], l1[2], l1[3], h1[0], h1[1], h1[2], h1[3]}, o[d0], 0, 0, 0);   \
        o[d0] = __builtin_amdgcn_mfma_f32_32x32x16_bf16(pa2, (bf16x8){l2[0], l2[1], l2[2], l2[3], h2[0], h2[1], h2[2], h2[3]}, o[d0], 0, 0, 0);   \
        o[d0] = __builtin_amdgcn_mfma_f32_32x32x16_bf16(pa3, (bf16x8){l3[0], l3[1], l3[2], l3[3], h3[0], h3[1], h3[2], h3[3]}, o[d0], 0, 0, 0); } while (0)
    PV_D0(0); PV_D0(1); PV_D0(2); PV_D0(3);
#undef PV_D0
#undef TRRD
}

struct Item {
    const bf16* Q; const bf16* K; const bf16* V; bf16* O; float* LSE;
    int qs, os, lse_s;
    int P0, nseq, R, kind, pack; float m0, m0b, l0;
};
struct Bases { unsigned char* ws; const float* sink; };
__device__ __forceinline__ void attn_make_item(Item& it, int w, int k, const Bases& B) {
    const bf16* proj = (const bf16*)(B.ws + WS_PROJ); bf16* ocat = (bf16*)(B.ws + WS_OCAT); bf16* ob = (bf16*)(B.ws + WS_OB); float* lb = (float*)(B.ws + WS_LB); const float* sink = B.sink;
    it.LSE = nullptr; it.lse_s = 0; it.m0 = -1e30f; it.l0 = 0.f; it.qs = HD; it.os = KBR; it.nseq = SEQ; it.R = 128; it.kind = 0; it.pack = 0; it.m0b = 0.f;
    if (k < 2) {
        const int a = w + 256 * k, b = a >> 7, kvh = (a >> 6) & 1, pr = (a >> 5) & 1, blk = a & 31, h = 4 * kvh + 2 * pr; const bf16* pb = proj + (size_t)b * SEQ * HD;
        it.Q = pb + (size_t)(OFF_QA / HD + h) * M * HD; it.K = pb + (size_t)(OFF_KA / HD + kvh) * M * HD; it.V = pb + (size_t)(OFF_VA / HD + kvh) * M * HD; it.O = ocat + (size_t)b * SEQ * KBR + OC_A + 128 * h;
        it.P0 = blk * 128; it.pack = 1; it.m0 = sink[h] * (1.0f / ATT_SCALE); it.m0b = sink[h + 1] * (1.0f / ATT_SCALE); it.l0 = 1.f;
    } else if (k < 4) {
        const int c = w + 256 * (k - 2), b = c >> 7, h = (c >> 4) & 7, blk = c & 15; const bf16* pb = proj + (size_t)b * SEQ * HD;
        it.Q = pb + (size_t)(OFF_QC / HD + h) * M * HD; it.K = pb + (size_t)(OFF_KC / HD + h) * M * HD; it.V = pb + (size_t)(OFF_VC / HD + h) * M * HD; it.O = ocat + (size_t)b * SEQ * KBR + OC_C + 128 * h;
        it.P0 = blk * 256; it.kind = 1;
    } else {
        const int g = k - 4, i = w, b = i >> 6, hg = (i >> 4) & 3; int r, blk, dil;
        if (g == 0) { dil = 1; r = 0; blk = i & 15; } else if (g == 1) { dil = 4; r = (i >> 2) & 3; blk = i & 3; } else { dil = 16; r = i & 15; blk = 0; }
        const int head = 4 * g + hg; const size_t row0 = (size_t)b * SEQ + r; const bf16* pb = proj + row0 * HD;
        it.Q = pb + (size_t)(OFF_QB / HD + head) * M * HD; it.K = pb + (size_t)(OFF_KB / HD + head) * M * HD; it.V = pb + (size_t)(OFF_VB / HD + head) * M * HD;
        it.O = ob + ((size_t)g * M + row0) * 512 + 128 * hg; it.LSE = lb + ((size_t)g * M + row0) * 4 + hg;
        it.qs = dil * HD; it.os = dil * 512; it.lse_s = dil * 4; it.nseq = SEQ / dil; it.R = 64; it.P0 = blk * 256;
    }
}
struct Pre { bf16x8 v0, v1; };
__device__ __forceinline__ int item_jlo(const Item& it) {
    if (it.kind == 0) return (it.P0 - it.R) < 0 ? 0 : (it.P0 - it.R) / KVBLK;
    const int r0 = it.P0 >> 6; int a_ = r0 - 4; a_ = a_ < 0 ? 0 : (a_ > 56 ? 56 : a_); return a_;
}
__device__ __forceinline__ void item_prefetch_k(const Item& it, char* lds) {
    int tid = threadIdx.x; asm volatile("" : "+v"(tid));
    const int wid = __builtin_amdgcn_readfirstlane(tid >> 6);
    const int sr = tid >> 4, sck = ((tid & 15) ^ (sr & 7)) * 8;
    const unsigned rb_ = (unsigned)((item_jlo(it) * KVBLK + sr) * it.qs), r1_ = (unsigned)(32 * it.qs);
    __builtin_amdgcn_global_load_lds((const GAS unsigned*)(it.K + rb_ + sck), (LAS unsigned*)(lds + 2 * SHM_V + wid * 1024), 16, 0, 0);
    __builtin_amdgcn_global_load_lds((const GAS unsigned*)(it.K + rb_ + r1_ + sck), (LAS unsigned*)(lds + 2 * SHM_V + 32 * 256 + wid * 1024), 16, 0, 0);
}
__device__ __forceinline__ void item_prefetch_v(const Item& it, Pre& p) {
    int tid = threadIdx.x; asm volatile("" : "+v"(tid));
    const int sr = tid >> 4, sc = (tid & 15) * 8;
    const unsigned rb_ = (unsigned)((item_jlo(it) * KVBLK + sr) * it.qs), r1_ = (unsigned)(32 * it.qs);
    p.v0 = *(const bf16x8*)(it.V + rb_ + sc); p.v1 = *(const bf16x8*)(it.V + rb_ + r1_ + sc);
}
__device__ __forceinline__ void item_prefetch_q(const Item& it, char* lds) {
    int tid = threadIdx.x; asm volatile("" : "+v"(tid));
    const int wid = __builtin_amdgcn_readfirstlane(tid >> 6), lane = tid & 63, r32 = lane & 31, hi = lane >> 5;
    const int hsel = it.pack ? (wid >> 2) : 0, wrow = it.pack ? (wid & 3) : wid;
    const int qpos = it.P0 + wrow * QBLK + r32;
    const bf16* qp = it.Q + (unsigned)(qpos * it.qs + hi * 8 + hsel * (M * HD));
#pragma unroll
    for (int d0 = 0; d0 < 8; ++d0)
        __builtin_amdgcn_global_load_lds((const GAS unsigned*)(qp + d0 * 16), (LAS unsigned*)(lds + Q_OFF + d0 * 8192 + wid * 1024), 16, 0, 0);
}
template <int G> __device__ __forceinline__ void bias8(unsigned bpa, float (&b0)[4], float (&b1)[4]) {
#define BRD_(dst, off) asm volatile("ds_read_b32 %0, %1 offset:%2" : "=v"(dst) : "v"(bpa), "i"(off) : "memory")
    BRD_(b0[0], (8 * G + 0) * 4); BRD_(b0[1], (8 * G + 1) * 4); BRD_(b0[2], (8 * G + 2) * 4); BRD_(b0[3], (8 * G + 3) * 4);
    BRD_(b1[0], (8 * G + 32) * 4); BRD_(b1[1], (8 * G + 33) * 4); BRD_(b1[2], (8 * G + 34) * 4); BRD_(b1[3], (8 * G + 35) * 4);
#undef BRD_
    asm volatile("s_waitcnt lgkmcnt(0)" : "+v"(b0[0]), "+v"(b0[1]), "+v"(b0[2]), "+v"(b0[3]), "+v"(b1[0]), "+v"(b1[1]), "+v"(b1[2]), "+v"(b1[3]) :: "memory");
}
__device__ __forceinline__ void attn_item(const Item& it, char* lds, Pre& pre, bool has_next, int w, int kn, const Bases& B) {
    const int KIND = it.kind;
    int tid = threadIdx.x; asm volatile("" : "+v"(tid));
    const int wid = __builtin_amdgcn_readfirstlane(tid >> 6), lane = tid & 63, r32 = lane & 31, hi = lane >> 5;
    char* V_lds = lds; char* K_lds = lds + 2 * SHM_V;
    float* ws = (float*)(lds + WS_OFF) + wid * 64; float* li_l = ws; float* al_l = ws + 32;
    const float* bias_l = (const float*)(lds + BIAS_OFF);
    const int hsel = it.pack ? (wid >> 2) : 0, wrow = it.pack ? (wid & 3) : wid, nrows = it.pack ? 128 : QB;
    const int qlo = it.P0 + wrow * QBLK, qpos = qlo + r32;
    int j_lo, j_hi;
    if (KIND == 0) { j_lo = (it.P0 - it.R) < 0 ? 0 : (it.P0 - it.R) / KVBLK; j_hi = (it.P0 + nrows - 1 + it.R) / KVBLK + 1; if (j_hi > it.nseq / KVBLK) j_hi = it.nseq / KVBLK; }
    else { const int r0 = it.P0 >> 6; int a = r0 - 4; a = a < 0 ? 0 : (a > 56 ? 56 : a); int b = r0 + 3 - 4; b = b < 0 ? 0 : (b > 56 ? 56 : b); j_lo = a; j_hi = b + 8; }
    const int NT = j_hi - j_lo;
    int wa, wb;
    if (KIND == 0) { wa = (qlo - it.R) < 0 ? 0 : (qlo - it.R) / KVBLK; wb = (qlo + QBLK - 1 + it.R) / KVBLK + 1; }
    else { const int qr = qlo >> 6; int a = qr - 4; a = a < 0 ? 0 : (a > 56 ? 56 : a); wa = a; wb = a + 8; }
    char* ql = lds + Q_OFF + tid * 16;

    const int sr = tid >> 4, sc = (tid & 15) * 8, vst0 = v_st(sr, sc), vst1 = v_st(32 + sr, sc), kws = KSWZ(sr, sc * 2);
    const int vb0 = (int)(uintptr_t)V_lds + v_rd_base(lane);
    bf16x8 st_k0, st_k1, st_v0, st_v1;
#define SLOAD(t) do { const unsigned r0_ = (unsigned)(((j_lo + (t)) * KVBLK + sr) * it.qs + sc), r1_ = r0_ + (unsigned)(32 * it.qs);   \
        st_v0 = *(const bf16x8*)(it.V + r0_); st_v1 = *(const bf16x8*)(it.V + r1_); st_k0 = *(const bf16x8*)(it.K + r0_); st_k1 = *(const bf16x8*)(it.K + r1_); } while (0)
#define SWRITE(bf) do { *(bf16x8*)(V_lds + (bf) * SHM_V + vst0) = st_v0; *(bf16x8*)(V_lds + (bf) * SHM_V + vst1) = st_v1;   \
        *(bf16x8*)(K_lds + (bf) * SHM_K + kws) = st_k0; *(bf16x8*)(K_lds + (bf) * SHM_K + kws + 32 * 256) = st_k1; } while (0)
#define ACT(t) ((j_lo + (t)) >= wa && (j_lo + (t)) < wb)
#define MASKC_G(P0_, P1_, g) do { float b0_[4], b1_[4]; bias8<g>(bpa, b0_, b1_);                                                              \
        _Pragma("unroll") for (int i_ = 0; i_ < 4; ++i_) { const int r = 4 * (g) + i_, c = i_ + 8 * (g);                                        \
            P0_[r] = ((unsigned)(kc0 + c) < 16u) ? P0_[r] + b0_[i_] : NEG; P1_[r] = ((unsigned)(kc0 + c + 32) < 16u) ? P1_[r] + b1_[i_] : NEG; } \
        SBAR(); } while (0)
#define MASKT(P0_, P1_, t) do { if (ACT(t)) { const int jt_ = j_lo + (t); const float NEG = -__builtin_inff();                            \
        if (KIND == 0) { if (!(jt_ * KVBLK + KVBLK - 1 - qlo <= it.R && qlo + QBLK - 1 - jt_ * KVBLK <= it.R)) {     \
            const int dq = qpos - jt_ * KVBLK - 4 * hi + it.R; const unsigned w2 = 2u * (unsigned)it.R;                                      \
            _Pragma("unroll") for (int r = 0; r < 16; ++r) { const int c = (r & 3) + 8 * (r >> 2);                                          \
                if ((unsigned)(dq - c) > w2) P0_[r] = NEG; if ((unsigned)(dq - c - 32) > w2) P1_[r] = NEG; } } }                            \
        else { const int qc = qpos & 63, qrow = qpos >> 6; int cs = qc - 8; cs = cs < 0 ? 0 : (cs > 48 ? 48 : cs);                          \
            const unsigned bpa = (unsigned)(uintptr_t)(bias_l + ((jt_ - qrow + 7) * 31 + 15 - qc + 4 * hi)); const int kc0 = 4 * hi - cs;      \
            MASKC_G(P0_, P1_, 0); MASKC_G(P0_, P1_, 1); MASKC_G(P0_, P1_, 2); MASKC_G(P0_, P1_, 3); } } } while (0)
#define RESC(a) do { if (__any((a) < 1.f)) { if (hi == 0) al_l[r32] = (a); asm volatile("s_waitcnt lgkmcnt(0)" ::: "memory");              \
        _Pragma("unroll") for (int d_ = 0; d_ < 4; ++d_) _Pragma("unroll") for (int r = 0; r < 16; ++r) o[d_][r] *= al_l[crow(r, hi)]; } } while (0)
    float m_reg = hsel ? it.m0b : it.m0, l_reg = it.l0; f32x16 o[4] = {};
    f32x16 pA0, pA1, pB0, pB1; float mnA, mnB, alA, alB; bf16x8 pa0, pa1, pa2, pa3;
    *(bf16x8*)(V_lds + vst0) = pre.v0; *(bf16x8*)(V_lds + vst1) = pre.v1;
    if (NT > 1) { SLOAD(1); asm volatile("s_waitcnt vmcnt(4)" ::: "memory"); } else asm volatile("s_waitcnt vmcnt(0)" ::: "memory");
    __syncthreads();
    SBAR(); qkt<0>(pA0, pA1, K_lds, r32, hi, ql, ACT(0));
    MASKT(pA0, pA1, 0); partialSM(pA0, pA1, m_reg, mnA, alA);
    if (NT > 1) SWRITE(1);
    __syncthreads();
#define HALF_STEP(PX0, PX1, mnX, alX, PY0, PY1, alY, t, KB, VB, SB) do {                                                      \
        SBAR(); qkt<KB>(PX0, PX1, K_lds, r32, hi, ql, ACT(t));                                                               \
        finishSM(PY0, PY1, alY, l_reg, pa0, pa1, pa2, pa3); SBAR();                                                           \
        if ((t) + 1 < NT) { SLOAD((t) + 1); SBAR(); }                                                                         \
        pv_tile<VB>(o, vb0, pa0, pa1, pa2, pa3, ACT((t) - 1)); MASKT(PX0, PX1, (t)); partialSM(PX0, PX1, m_reg, mnX, alX);     \
        __syncthreads();                                                                                                      \
        if ((t) + 1 < NT) { SWRITE(SB); }                                                                                     \
        RESC(alX); __syncthreads(); } while (0)
    for (int t = 1; t + 1 < NT; t += 2) {
        HALF_STEP(pB0, pB1, mnB, alB, pA0, pA1, alA, t, 1, 0, 0);
        HALF_STEP(pA0, pA1, mnA, alA, pB0, pB1, alB, t + 1, 0, 1, 1);
    }
    const bool even = (NT & 1) == 0;
    if (even) { SBAR(); qkt<1>(pB0, pB1, K_lds, r32, hi, ql, ACT(NT - 1)); SBAR(); }
    finishSM(pA0, pA1, alA, l_reg, pa0, pa1, pa2, pa3); SBAR();
    pv_tile<0>(o, vb0, pa0, pa1, pa2, pa3, ACT(even ? NT - 2 : NT - 1));
    if (even) { MASKT(pB0, pB1, NT - 1); partialSM(pB0, pB1, m_reg, mnB, alB); RESC(alB);
        finishSM(pB0, pB1, alB, l_reg, pa0, pa1, pa2, pa3); SBAR(); pv_tile<1>(o, vb0, pa0, pa1, pa2, pa3, ACT(NT - 1)); }
#undef HALF_STEP
#undef RESC
#undef MASKT
#undef MASKC_G
#undef ACT
#undef SLOAD
#undef SWRITE
    if (has_next) { Item nx; attn_make_item(nx, w, kn, B); item_prefetch_k(nx, lds); }
    if (hi == 0) li_l[r32] = l_reg; asm volatile("s_waitcnt lgkmcnt(0)" ::: "memory");
    { char* ob_ = lds + Q_OFF + wid * 1024;
      const bool odd = (r32 & 1) != 0; char* wp = ob_ + hi * 8192 + (odd ? (r32 - 1) * 2 + 256 : r32 * 2);
      f32x4 rl4[4];
#pragma unroll
      for (int g = 0; g < 4; ++g) rl4[g] = *(const f32x4*)(li_l + 8 * g + 4 * hi);
#pragma unroll
      for (int r = 0; r < 16; r += 2) { const float ra = __builtin_amdgcn_rcpf(rl4[r >> 2][r & 3]), rb = __builtin_amdgcn_rcpf(rl4[r >> 2][(r & 3) + 1]);
#pragma unroll
          for (int d0 = 0; d0 < 4; ++d0) { const float va = o[d0][r] * ra, vb = o[d0][r + 1] * rb;
              const float y = lane_xor1(odd ? va : vb);
              *(unsigned*)(wp + (2 * (r >> 2)) * 8192 + (r & 3) * 256 + d0 * 64) = cvt_pk_bf16(odd ? y : va, odd ? vb : y); } }
      asm volatile("s_waitcnt lgkmcnt(0)" ::: "memory");
      bf16* Og = it.O + (unsigned)((qlo + (lane >> 4)) * it.os + hsel * HD + (lane & 15) * 8);
#pragma unroll
      for (int j = 0; j < 8; ++j) { const v4u w = *(const v4u*)(ob_ + j * 8192 + lane * 16); *(v4u*)(Og + (unsigned)(4 * j * it.os)) = w; } }
    if (has_next) { asm volatile("s_waitcnt lgkmcnt(0)" ::: "memory"); Item nx; attn_make_item(nx, w, kn, B); item_prefetch_q(nx, lds); item_prefetch_v(nx, pre); }
    else { pre.v0 = (bf16x8){0, 0, 0, 0, 0, 0, 0, 0}; pre.v1 = pre.v0; }
    if (it.LSE != nullptr && hi == 0) it.LSE[(unsigned)(qpos * it.lse_s)] = m_reg * ATT_SCALE + __logf(l_reg);
    __syncthreads();
}
#undef KSWZ
#undef SBAR
}
template <int MAP> __device__ __forceinline__ void cvt_unit(const float* __restrict__ W, int N, bf16* __restrict__ Bt, int ldb, int koff, const float* __restrict__ gain, int n0, int k0, int lane) {
    const int kg = lane >> 3, ng = lane & 7, nn0 = n0 + 4 * ng, r0 = map_row<MAP>(nn0);
#pragma unroll 1
    for (int pass = 0; pass < 4; pass += 2) {
        f32x4 v[2][8];
#pragma unroll
        for (int p = 0; p < 2; ++p)
#pragma unroll
            for (int i = 0; i < 8; ++i) v[p][i] = __builtin_nontemporal_load((const f32x4*)(W + (size_t)(k0 + (pass + p) * 64 + 8 * kg + i) * N + nn0));
#pragma unroll
        for (int p = 0; p < 2; ++p) { const int kb = k0 + (pass + p) * 64 + 8 * kg;
            f32x4 g0 = {1.f, 1.f, 1.f, 1.f}, g1 = {1.f, 1.f, 1.f, 1.f};
            if (gain) { g0 = *(const f32x4*)(gain + kb); g1 = *(const f32x4*)(gain + kb + 4); }
#pragma unroll
            for (int nn = 0; nn < 4; ++nn) { v4u o;
                o.x = cvt_pk_bf16(v[p][0][nn] * g0[0], v[p][1][nn] * g0[1]); o.y = cvt_pk_bf16(v[p][2][nn] * g0[2], v[p][3][nn] * g0[3]);
                o.z = cvt_pk_bf16(v[p][4][nn] * g1[0], v[p][5][nn] * g1[1]); o.w = cvt_pk_bf16(v[p][6][nn] * g1[2], v[p][7][nn] * g1[3]);
                *(v4u*)(Bt + (size_t)(r0 + nn) * ldb + koff + kb) = o; } }
    }
}

struct Args { const float* in[13]; float* out; unsigned char* ws; int ph_lo, ph_hi; };
#define CAS __attribute__((address_space(4)))
#define GIN(k) ((const float*)(const GAS float*)ap->in[k])
#define GOUT ((float*)(GAS float*)ap->out)
struct Frame {
    LAS unsigned char* lds;
    int tid, lane, wave, G, gw, ngw, bx;
    unsigned char* ws;
};

constexpr int CU_IN = (NIN / 32) * (DM / 256), CU_BA = (DM / 32) * (1024 / 256), CU_BB = (DM / 32) * (512 / 256), CU_BC = CU_BA, CU_O = (DM / 32) * (DM / 256),
              CU_GU = (NGU / 32) * (DM / 256), CU_D = (DM / 32) * (DFF / 256), CU_LAYER = CU_IN + CU_BA + CU_BB + CU_BC + CU_O + CU_GU + CU_D;
static_assert(CU_LAYER == 9216, "conversion units per layer");

__device__ __forceinline__ void p0_prologue(const Frame& F, const CAS Args* ap) {
    { unsigned* rope = (unsigned*)(F.ws + WS_ROPE);
      for (int e = blockIdx.x * (NWAVES * 64) + F.tid; e < SEQ * 64; e += F.G * NWAVES * 64) { const int pos = e >> 6, i = e & 63;
          double fr_ = 1.0; { const double q1 = 0.86596432336006535, q2 = q1 * q1, q4 = q2 * q2, q8 = q4 * q4, q16 = q8 * q8, q32 = q16 * q16;
            if (i & 1) fr_ *= q1; if (i & 2) fr_ *= q2; if (i & 4) fr_ *= q4; if (i & 8) fr_ *= q8; if (i & 16) fr_ *= q16; if (i & 32) fr_ *= q32; }
          double r = (double)pos * (double)(float)fr_ * 0.15915494309189533577; r -= __builtin_floor(r);
          const float rf = (float)r; rope[e] = cvt_pk_f16(__builtin_amdgcn_cosf(rf), __builtin_amdgcn_sinf(rf)); } }
    for (int u = F.gw; u < DEPTH * CU_LAYER; u += F.ngw) {
        const int layer = u / CU_LAYER; int r = u - layer * CU_LAYER;
        bf16* wl = (bf16*)(F.ws + WS_W + (size_t)layer * LW_SZ);
        if (r < CU_IN) { cvt_unit<MAP_IN>(GIN(2) + (size_t)layer * DM * NIN, NIN, (bf16*)((char*)wl + LW_IN), DM, 0, GIN(1) + layer * DM, 32 * (r % (NIN / 32)), 256 * (r / (NIN / 32)), F.lane); continue; } r -= CU_IN;
        if (r < CU_BA) { cvt_unit<MAP_V>(GIN(6) + (size_t)layer * 1024 * DM, DM, (bf16*)((char*)wl + LW_BR), KBR, 0, nullptr, 32 * (r % (DM / 32)), 256 * (r / (DM / 32)), F.lane); continue; } r -= CU_BA;
        if (r < CU_BB) { cvt_unit<MAP_V>(GIN(7) + (size_t)layer * 512 * DM, DM, (bf16*)((char*)wl + LW_BR), KBR, 1024, nullptr, 32 * (r % (DM / 32)), 256 * (r / (DM / 32)), F.lane); continue; } r -= CU_BB;
        if (r < CU_BC) { cvt_unit<MAP_V>(GIN(8) + (size_t)layer * 1024 * DM, DM, (bf16*)((char*)wl + LW_BR), KBR, 1536, nullptr, 32 * (r % (DM / 32)), 256 * (r / (DM / 32)), F.lane); continue; } r -= CU_BC;
        if (r < CU_O) { cvt_unit<MAP_V>(GIN(9) + (size_t)layer * DM * DM, DM, (bf16*)((char*)wl + LW_O), DM, 0, nullptr, 32 * (r % (DM / 32)), 256 * (r / (DM / 32)), F.lane); continue; } r -= CU_O;
        if (r < CU_GU) { cvt_unit<MAP_GU>(GIN(11) + (size_t)layer * DM * NGU, NGU, (bf16*)((char*)wl + LW_GU), DM, 0, GIN(10) + layer * DM, 32 * (r % (NGU / 32)), 256 * (r / (NGU / 32)), F.lane); continue; } r -= CU_GU;
        cvt_unit<MAP_V>(GIN(12) + (size_t)layer * DFF * DM, DM, (bf16*)((char*)wl + LW_D), DFF, 0, nullptr, 32 * (r % (DM / 32)), 256 * (r / (DM / 32)), F.lane);
    }
}

__device__ __forceinline__ void x_to_bf16_ssq(const Frame& F, const float* x, bf16* xb, float* ssq) {
    for (int row = F.gw; row < M; row += F.ngw) {
        const f32x4* xr = (const f32x4*)(x + (size_t)row * DM) + F.lane;
        f32x4 v[8]; float s[8];
#pragma unroll
        for (int j = 0; j < 8; ++j) { v[j] = xr[64 * j]; s[j] = (v[j][0] * v[j][0] + v[j][1] * v[j][1]) + (v[j][2] * v[j][2] + v[j][3] * v[j][3]); }
        v2u* o = (v2u*)(xb + (size_t)row * DM) + F.lane;
#pragma unroll
        for (int j = 0; j < 8; ++j) { v2u w; w.x = cvt_pk_bf16(v[j][0], v[j][1]); w.y = cvt_pk_bf16(v[j][2], v[j][3]); o[64 * j] = w; s[j] = wave_sum(s[j]); }
        if (F.lane == 0) { *(f32x4*)(ssq + (size_t)row * 8) = (f32x4){s[0], s[1], s[2], s[3]}; *(f32x4*)(ssq + (size_t)row * 8 + 4) = (f32x4){s[4], s[5], s[6], s[7]}; }
    }
}
__device__ __forceinline__ void rs_issue(const Frame& F, const float* ssq, int pbase, f32x4 (&s)[4][2]) {
#pragma unroll
    for (int i = 0; i < 4; ++i) { const f32x4* sp = (const f32x4*)(ssq + ((size_t)pbase * 256 + F.tid + i * (NWAVES * 64)) * 8); s[i][0] = sp[0]; s[i][1] = sp[1]; }
}
__device__ __forceinline__ void rs_table_load(const Frame& F, const float* ssq, int pbase, LAS float* RS) {
    f32x4 s[4][2];
#pragma unroll
    for (int i = 0; i < 4; ++i) { const f32x4* sp = (const f32x4*)(ssq + ((size_t)pbase * 256 + F.tid + i * (NWAVES * 64)) * 8); s[i][0] = sp[0]; s[i][1] = sp[1]; }
#pragma unroll
    for (int i = 0; i < 4; ++i) { const f32x4 s0 = s[i][0], s1 = s[i][1];
        RS[F.tid + i * (NWAVES * 64)] = __builtin_amdgcn_rsqf((((s0[0] + s0[1]) + (s0[2] + s0[3])) + ((s1[0] + s1[1]) + (s1[2] + s1[3]))) * (1.0f / DM) + NORM_EPS); }
    asm volatile("s_waitcnt lgkmcnt(0)" ::: "memory"); __syncthreads();
}
__device__ __forceinline__ void attn_phase(const Frame& F, char* lds, unsigned char* ws, const float* sink  , const float* rpb  ) {
    const int G = F.G; const att::Bases B{ws, sink};
#pragma unroll 1
    for (int w = F.bx; w < 256; w += G) {
        att::Pre pre;
        { att::Item it0; att::attn_make_item(it0, w, 0, B); att::item_prefetch_k(it0, lds); att::item_prefetch_q(it0, lds); att::item_prefetch_v(it0, pre); }
        { const int h = (w >> 4) & 7; float* bl = (float*)(lds + att::BIAS_OFF); for (int i = F.tid; i < 15 * 31; i += NWAVES * 64) bl[i] = rpb[h * 465 + i] * (1.0f / ATT_SCALE); }
#pragma unroll 1
        for (int k = 0; k < 7; ++k) {
            att::Item cur; att::attn_make_item(cur, w, k, B);
            att::attn_item(cur, lds, pre, k + 1 < 7, w, k + 1, B);
        }
        __syncthreads();
    }
}
template <int NR>
__device__ __forceinline__ void bcombine_rows_n(const bf16* ob, const float* lb, bf16* ocat, int row0, int rstep, int lane) {
    const int hg = lane >> 4, c8 = (lane & 15) * 8;
    float l[NR][3]; v4u w[NR][3];
#pragma unroll
    for (int i = 0; i < NR; ++i)
#pragma unroll
        for (int g = 0; g < 3; ++g) { const int row = row0 + i * rstep; l[i][g] = lb[((size_t)g * M + row) * 4 + hg]; w[i][g] = *(const v4u*)(ob + ((size_t)g * M + row) * 512 + 128 * hg + c8); }
#pragma unroll
    for (int i = 0; i < NR; ++i) { const int row = row0 + i * rstep;
        const float mx = fmaxf(l[i][0], fmaxf(l[i][1], l[i][2])); float e[3], s = 0.f;
#pragma unroll
        for (int g = 0; g < 3; ++g) { e[g] = __expf(l[i][g] - mx); s += e[g]; }
        const float inv = __builtin_amdgcn_rcpf(s); float acc[8] = {0.f, 0.f, 0.f, 0.f, 0.f, 0.f, 0.f, 0.f};
#pragma unroll
        for (int g = 0; g < 3; ++g) { const float wg = e[g] * inv; const v4u u = w[i][g];
            acc[0] += wg * bf_lo(u.x); acc[1] += wg * bf_hi(u.x); acc[2] += wg * bf_lo(u.y); acc[3] += wg * bf_hi(u.y);
            acc[4] += wg * bf_lo(u.z); acc[5] += wg * bf_hi(u.z); acc[6] += wg * bf_lo(u.w); acc[7] += wg * bf_hi(u.w); }
        v4u o; o.x = cvt_pk_bf16(acc[0], acc[1]); o.y = cvt_pk_bf16(acc[2], acc[3]); o.z = cvt_pk_bf16(acc[4], acc[5]); o.w = cvt_pk_bf16(acc[6], acc[7]);
        *(v4u*)(ocat + (size_t)row * KBR + OC_B + 128 * hg + c8) = o; }
}
__device__ __forceinline__ void bcombine_rows(const Frame& F, const bf16* ob, const float* lb, bf16* ocat) {
    int row = F.gw;
    for (; row + 3 * F.ngw < M; row += 4 * F.ngw) bcombine_rows_n<4>(ob, lb, ocat, row, F.ngw, F.lane);
    for (; row < M; row += F.ngw) bcombine_rows_n<1>(ob, lb, ocat, row, F.ngw, F.lane);
}

#ifndef MK_SINGLE
#define MK_SINGLE 1
#endif
constexpr int NPH = 7;
constexpr int NPHASES = 1 + DEPTH * NPH;
__global__ void __launch_bounds__(NWAVES * 64, 2) mk_fwd(Args args) {
    extern __shared__ __attribute__((aligned(16))) unsigned char lds[];
    const int tid0 = threadIdx.x;
    volatile LAS unsigned* MISC = (volatile LAS unsigned*)((LAS unsigned char*)lds + MISC_OFF);
    if (tid0 < 32) MISC[tid0] = 0u;
    __syncthreads();
    const int lo = args.ph_lo, hi = args.ph_hi; const bool multi = (hi - lo) > 1;
    XcdBarrier bar; bar.bar = (unsigned*)(args.ws + WS_CTL) + CW_BAR; bar.x = 0; bar.st = MISC + 8;
    if (multi) bar = xcd_barrier_post((unsigned*)(args.ws + WS_CTL) + CW_BAR, MISC + 8);
#define IN(k) (lo <= (k) && (k) < hi)
#define SEAM(k) do { if (IN((k) + 1)) xcd_barrier(bar); } while (0)


#define XN ((bf16*)(wsb + WS_XN))
#define PROJ ((bf16*)(wsb + WS_PROJ))
#define HID ((bf16*)(wsb + WS_HID))
#define OCAT ((bf16*)(wsb + WS_OCAT))
#define MRG ((bf16*)(wsb + WS_MRG))
#define MACC ((float*)(wsb + WS_MACC))
#define SSQB ((float*)(wsb + WS_SSQ))
#define XLO ((bf16*)(wsb + WS_XLO))
#define OB ((bf16*)(wsb + WS_OB))
#define LB ((float*)(wsb + WS_LB))
#define WL(off) ((const bf16*)(wsb + WS_W + (size_t)layer * LW_SZ + (off)))
#define OPQ() const CAS Args* ap; { const CAS char* kp_ = (const CAS char*)__builtin_amdgcn_kernarg_segment_ptr(); asm volatile("" : "+s"(kp_)); ap = (const CAS Args*)kp_; } GAS unsigned char* wsg_ = (GAS unsigned char*)ap->ws; asm volatile("" : "+s"(wsg_)); unsigned char* wsb = (unsigned char*)wsg_; Frame F; { int t_ = threadIdx.x; asm volatile("" : "+v"(t_)); F.lds = (LAS unsigned char*)lds; F.tid = t_; F.lane = t_ & 63; \
    F.wave = __builtin_amdgcn_readfirstlane(t_ >> 6); F.G = gridDim.x; { int bx_ = blockIdx.x; asm volatile("" : "+s"(bx_)); F.bx = bx_; } F.gw = F.bx * NWAVES + F.wave; F.ngw = F.G * NWAVES; F.ws = wsb; }
    if (IN(0)) { OPQ(); p0_prologue(F, ap); x_to_bf16_ssq(F, GIN(0), XN, SSQB); SEAM(0); }
#pragma unroll 1
    for (int layer_ = 0; layer_ < DEPTH; ++layer_) {
        int layer = layer_; asm volatile("" : "+s"(layer));
        const int pb = 1 + layer * NPH;
        if (pb >= hi || pb + NPH <= lo) continue;
        if (IN(pb + 0)) { OPQ(); pg8::Gemm g{XN, WL(LW_IN), DM, DM, M, NIN, DM}; pg8::StaticOrder S; S.init(M, NIN, F.G, F.bx); pg8::Unit u0; S.next(0, u0);
            pg8::EpiProj E{PROJ, GIN(3) + layer * 6 * HD, (const unsigned*)(wsb + WS_ROPE), (LAS float*)(F.lds + XCH_OFF), (const LAS float*)(F.lds + RS_OFF)}; rs_issue(F, SSQB, u0.pm & ~7, E.rsv);
            pg8::gemm_phase<pg8::EpiProj, pg8::StaticOrder, true, true>(F.lds + RING_OFF, g, S, E); SEAM(pb + 0); }
        if (IN(pb + 1)) { OPQ(); attn_phase(F, (char*)lds, wsb, GIN(4) + layer * 8, GIN(5) + layer * 8 * 15 * 31); SEAM(pb + 1); }
        if (IN(pb + 2)) { OPQ(); bcombine_rows(F, OB, LB, OCAT); xcd_split_arrive(bar, (unsigned*)(wsb + WS_CTL) + CW_SPLIT + layer * 2048); }
        if (IN(pb + 3)) { OPQ(); pg8::Gemm g{OCAT, WL(LW_BR), KBR, KBR, M, DM, KBR}; pg8::StaticOrder S; S.init(M, DM, F.G, F.bx); pg8::EpiBranch E{wsb, layer, MISC + 8};
            pg8::gemm_phase<pg8::EpiBranch, pg8::StaticOrder, true, true>(F.lds + RING_OFF, g, S, E); SEAM(pb + 3); }
        if (IN(pb + 4)) { OPQ(); pg8::Gemm g{MRG, WL(LW_O), DM, DM, M, DM, DM}; pg8::StaticOrder S; S.init(M, DM, F.G, F.bx); pg8::EpiResNorm E{(float*)nullptr, XN, SSQB, (LAS float*)(F.lds + XCH_OFF)};
            pg8::gemm_phase<pg8::EpiResNorm, pg8::StaticOrder, true, true>(F.lds + RING_OFF, g, S, E); SEAM(pb + 4); }
        if (IN(pb + 5)) { OPQ(); pg8::Gemm g{XN, WL(LW_GU), DM, DM, M, NGU, DM}; pg8::StaticOrder S; S.init(M, NGU, F.G, F.bx); pg8::Unit u0; S.next(0, u0);
            pg8::EpiSwiglu E{HID, (const LAS float*)(F.lds + RS_OFF)}; rs_issue(F, SSQB, u0.pm & ~7, E.rsv);
            pg8::gemm_phase<pg8::EpiSwiglu, pg8::StaticOrder, true, true>(F.lds + RING_OFF, g, S, E); SEAM(pb + 5); }
        if (IN(pb + 6)) { OPQ(); pg8::Gemm g{HID, WL(LW_D), DFF, DFF, M, DM, DFF}; pg8::StaticOrder S; S.init(M, DM, F.G, F.bx); pg8::EpiResNorm E{layer == DEPTH - 1 ? GOUT : (float*)nullptr, XN, SSQB, (LAS float*)(F.lds + XCH_OFF)};
            pg8::gemm_phase<pg8::EpiResNorm, pg8::StaticOrder, true, true>(F.lds + RING_OFF, g, S, E); SEAM(pb + 6); }
    }
#undef IN
#undef SEAM
}

extern "C" void kernel_launch(void* const* d_in, const int* in_sizes, int n_in, void* d_out, int out_size, void* d_ws, size_t ws_size, hipStream_t stream) {
    static int grid = 0;
    if (grid == 0) {
        if (n_in != 13 || in_sizes[0] != M * DM || out_size != M * DM || ws_size < WS_END) { fprintf(stderr, "kernel_launch: unexpected shapes (n_in %d, in0 %d, out %d, ws %zu; need ws >= %zu); nothing launched\n", n_in, n_in > 0 ? in_sizes[0] : -1, out_size, ws_size, (size_t)WS_END); grid = -1; return; }
        int dev = 0, cus = 0, per_cu = 0;
        if (hipGetDevice(&dev) != hipSuccess || hipDeviceGetAttribute(&cus, hipDeviceAttributeMultiprocessorCount, dev) != hipSuccess) { grid = -1; return; }
        if (hipFuncSetAttribute((const void*)mk_fwd, hipFuncAttributeMaxDynamicSharedMemorySize, LDS_BYTES) != hipSuccess) { fprintf(stderr, "kernel_launch: hipFuncSetAttribute failed\n"); grid = -1; return; }
        if (hipOccupancyMaxActiveBlocksPerMultiprocessor(&per_cu, (const void*)mk_fwd, NWAVES * 64, LDS_BYTES) != hipSuccess || per_cu < 1) fprintf(stderr, "kernel_launch: occupancy query reports %d workgroups per CU\n", per_cu);
        (void)hipGetLastError();
        grid = cus;
    }
    if (grid < 0) return;
    if (hipMemsetAsync((char*)d_ws + WS_CTL, 0, CTL_ZERO_BYTES, stream) != hipSuccess) return;
    Args a{};
    for (int i = 0; i < 13; ++i) a.in[i] = (const float*)d_in[i];
    a.out = (float*)d_out; a.ws = (unsigned char*)d_ws;
#if MK_SINGLE
    a.ph_lo = 0; a.ph_hi = NPHASES;
    hipLaunchKernelGGL(mk_fwd, dim3(grid), dim3(NWAVES * 64), LDS_BYTES, stream, a);
#else
    for (int p = 0; p < NPHASES; ++p) { a.ph_lo = p; a.ph_hi = p + 1; hipLaunchKernelGGL(mk_fwd, dim3(grid), dim3(NWAVES * 64), LDS_BYTES, stream, a); }
#endif
    const hipError_t le = hipPeekAtLastError();
    if (le != hipSuccess) fprintf(stderr, "kernel_launch: launch failed: %s\n", hipGetErrorName(le));
}
```
